# Optimizing an MI355X kernel written in HIP

```python
import math
import jax, jax.numpy as jnp
from jax import lax
import numpy as np

D_MODEL = 1024
BATCH = 32
SEQ = 2048
DEPTH = 2

GRID_W = 64
MIX_WIDTH = D_MODEL
ATTN_WIDTH = MIX_WIDTH // 2
SSM_WIDTH = MIX_WIDTH - ATTN_WIDTH
HEAD_DIM = 64
N_HEADS = ATTN_WIDTH // HEAD_DIM
WIN_ROWS_MAX = 8
WIN_COLS = 16
SSM_GROUP = 16
N_SSM_GROUPS = SSM_WIDTH // SSM_GROUP
SSM_STATE = 64
D_FF = 4 * D_MODEL
IN_COLS = 3 * ATTN_WIDTH + SSM_WIDTH
N_MOD = 6
EPS = 1e-6
DT_MIN = 1e-3
DT_MAX = 1e-1
NEG_INF = -1e30

kernel_name = "hybrid_natten_s5_encoder_block"


def _rmsnorm(x, g):
    xf = x.astype(jnp.float32)
    y = xf * lax.rsqrt(jnp.mean(jnp.square(xf), axis=-1, keepdims=True) + EPS)
    return (y * g.astype(jnp.float32)).astype(x.dtype)


def _neighbourhood_attention(q, k, v, q_g, k_g, rel_bias, rows):
    bsz, seq_len, _ = q.shape
    win_rows = min(WIN_ROWS_MAX, rows)
    scale = HEAD_DIM ** -0.5

    def to_grid(t, g):
        t = t.reshape(bsz, rows, GRID_W, N_HEADS, HEAD_DIM)
        if g is not None:
            t = _rmsnorm(t, g)
        return t.transpose(0, 3, 1, 2, 4)

    qg = to_grid(q, q_g)
    kg = to_grid(k, k_g)
    vg = to_grid(v, None)

    qc = jnp.arange(GRID_W)
    col_start = jnp.clip(qc - WIN_COLS // 2, 0, GRID_W - WIN_COLS)
    kc = jnp.arange(GRID_W)
    col_valid = (kc[None, :] >= col_start[:, None]) & (kc[None, :] < col_start[:, None] + WIN_COLS)
    col_off = jnp.clip(kc[None, :] - qc[:, None] + WIN_COLS - 1, 0, 2 * WIN_COLS - 2)
    bias_cols = rel_bias.astype(jnp.float32)[:, :, col_off]

    def row_block(r):
        r0 = jnp.clip(r - win_rows // 2, 0, rows - win_rows)
        qb = lax.dynamic_index_in_dim(qg, r, axis=2, keepdims=False)
        kb = lax.dynamic_slice_in_dim(kg, r0, win_rows, axis=2)
        vb = lax.dynamic_slice_in_dim(vg, r0, win_rows, axis=2)
        s = jnp.einsum('bhqd,bhjkd->bhqjk', qb, kb).astype(jnp.float32) * scale
        dr = r0 + jnp.arange(win_rows) - r + WIN_ROWS_MAX - 1
        bias = jnp.take(bias_cols, dr, axis=1).transpose(0, 2, 1, 3)
        s = jnp.where(col_valid[:, None, :], s + bias, NEG_INF)
        p = jax.nn.softmax(s.reshape(bsz, N_HEADS, GRID_W, win_rows * GRID_W), axis=-1)
        p = p.reshape(s.shape).astype(vb.dtype)
        return jnp.einsum('bhqjk,bhjkd->bhqd', p, vb)

    out = lax.map(row_block, jnp.arange(rows))
    return out.transpose(1, 0, 3, 2, 4).reshape(bsz, seq_len, ATTN_WIDTH)


def _ssm_combine(left, right):
    a_l, b_l = left
    a_r, b_r = right
    return a_l * a_r, a_r * b_l + b_r


def _s5_glu(u, lam_re, lam_im, log_dt, b_re, b_im, c_re, c_im, d_skip, w_glu):
    bsz, seq_len, _ = u.shape
    ug = u.astype(jnp.float32).reshape(bsz, seq_len, N_SSM_GROUPS, SSM_GROUP)
    uc = ug.astype(jnp.complex64)
    y = d_skip.astype(jnp.float32) * ug
    for direction in range(2):
        lam = lax.complex(jnp.minimum(lam_re[direction].astype(jnp.float32), -1e-4),
                          lam_im[direction].astype(jnp.float32))
        dt = jnp.exp(log_dt[direction].astype(jnp.float32))[:, None]
        lam_bar = jnp.exp(lam * dt)
        b = lax.complex(b_re[direction].astype(jnp.float32), b_im[direction].astype(jnp.float32))
        b_bar = ((lam_bar - 1.0) / lam)[..., None] * b
        bu = jnp.einsum('blgh,gph->lbgp', uc, b_bar)
        a = jnp.broadcast_to(lam_bar, (seq_len, 1, N_SSM_GROUPS, SSM_STATE))
        _, states = lax.associative_scan(_ssm_combine, (a, bu), axis=0, reverse=(direction == 1))
        cm = lax.complex(c_re[direction].astype(jnp.float32), c_im[direction].astype(jnp.float32))
        y = y + jnp.real(jnp.einsum('lbgp,ghp->blgh', states, cm))
    y = y.reshape(bsz, seq_len, SSM_WIDTH)
    z = jax.nn.gelu(y)
    return (z * jax.nn.sigmoid(z @ w_glu.astype(jnp.float32))).astype(u.dtype)


def setup_inputs(seed: int = 0) -> dict:
    key = jax.random.key(seed)
    ks = jax.random.split(key, 26)
    n = jax.random.normal
    f32 = jnp.float32
    x = n(ks[0], (BATCH, SEQ, D_MODEL), f32)
    c = n(ks[1], (BATCH, D_MODEL), f32)
    norm1_g = 1.0 + 0.02 * n(ks[2], (DEPTH, D_MODEL), f32)
    norm2_g = 1.0 + 0.02 * n(ks[3], (DEPTH, D_MODEL), f32)
    w_ada = 0.5 * D_MODEL ** -0.5 * n(ks[4], (DEPTH, D_MODEL, N_MOD * D_MODEL), f32)
    b_ada = 0.01 * n(ks[5], (DEPTH, N_MOD * D_MODEL), f32)
    w_in = D_MODEL ** -0.5 * n(ks[6], (DEPTH, D_MODEL, IN_COLS), f32)
    q_norm_g = 1.0 + 0.02 * n(ks[7], (DEPTH, HEAD_DIM), f32)
    k_norm_g = 1.0 + 0.02 * n(ks[8], (DEPTH, HEAD_DIM), f32)
    rel_bias = 0.1 * n(ks[9], (DEPTH, N_HEADS, 2 * WIN_ROWS_MAX - 1, 2 * WIN_COLS - 1), f32)
    ssm_lambda_re = -0.5 + 0.01 * n(ks[10], (DEPTH, 2, N_SSM_GROUPS, SSM_STATE), f32)
    ssm_lambda_im = (math.pi * jnp.arange(SSM_STATE, dtype=f32)
                     + 0.01 * n(ks[11], (DEPTH, 2, N_SSM_GROUPS, SSM_STATE), f32))
    ssm_log_dt = jax.random.uniform(ks[12], (DEPTH, 2, N_SSM_GROUPS), f32,
                                    minval=math.log(DT_MIN), maxval=math.log(DT_MAX))
    b_scale = (2.0 * SSM_GROUP) ** -0.5
    c_scale = (2.0 * SSM_STATE) ** -0.5
    ssm_b_re = b_scale * n(ks[13], (DEPTH, 2, N_SSM_GROUPS, SSM_STATE, SSM_GROUP), f32)
    ssm_b_im = b_scale * n(ks[14], (DEPTH, 2, N_SSM_GROUPS, SSM_STATE, SSM_GROUP), f32)
    ssm_c_re = c_scale * n(ks[15], (DEPTH, 2, N_SSM_GROUPS, SSM_GROUP, SSM_STATE), f32)
    ssm_c_im = c_scale * n(ks[16], (DEPTH, 2, N_SSM_GROUPS, SSM_GROUP, SSM_STATE), f32)
    ssm_d = n(ks[17], (DEPTH, N_SSM_GROUPS, SSM_GROUP), f32)
    w_glu = SSM_WIDTH ** -0.5 * n(ks[18], (DEPTH, SSM_WIDTH, SSM_WIDTH), f32)
    attn_out_g = 1.0 + 0.02 * n(ks[19], (DEPTH, ATTN_WIDTH), f32)
    ssm_out_g = 1.0 + 0.02 * n(ks[20], (DEPTH, SSM_WIDTH), f32)
    w_out = MIX_WIDTH ** -0.5 * n(ks[21], (DEPTH, MIX_WIDTH, D_MODEL), f32)
    w_mlp1 = D_MODEL ** -0.5 * n(ks[22], (DEPTH, D_MODEL, D_FF), f32)
    w_mlp2 = D_FF ** -0.5 * n(ks[23], (DEPTH, D_FF, D_MODEL), f32)
    return {"x": x, "c": c, "norm1_g": norm1_g, "norm2_g": norm2_g, "w_ada": w_ada,
            "b_ada": b_ada, "w_in": w_in, "q_norm_g": q_norm_g, "k_norm_g": k_norm_g,
            "rel_bias": rel_bias, "ssm_lambda_re": ssm_lambda_re, "ssm_lambda_im": ssm_lambda_im,
            "ssm_log_dt": ssm_log_dt, "ssm_b_re": ssm_b_re, "ssm_b_im": ssm_b_im,
            "ssm_c_re": ssm_c_re, "ssm_c_im": ssm_c_im, "ssm_d": ssm_d, "w_glu": w_glu,
            "attn_out_g": attn_out_g, "ssm_out_g": ssm_out_g, "w_out": w_out,
            "w_mlp1": w_mlp1, "w_mlp2": w_mlp2}


def reference(x, c, norm1_g, norm2_g, w_ada, b_ada, w_in, q_norm_g, k_norm_g, rel_bias,
              ssm_lambda_re, ssm_lambda_im, ssm_log_dt, ssm_b_re, ssm_b_im, ssm_c_re, ssm_c_im,
              ssm_d, w_glu, attn_out_g, ssm_out_g, w_out, w_mlp1, w_mlp2):
    bsz, seq_len, _ = x.shape
    rows = seq_len // GRID_W
    for i in range(DEPTH):
        mod = jax.nn.silu(c) @ w_ada[i] + b_ada[i]
        sh1, sc1, g1, sh2, sc2, g2 = jnp.split(mod[:, None, :], N_MOD, axis=-1)

        h = _rmsnorm(x, norm1_g[i]) * (1.0 + sc1) + sh1
        proj = h @ w_in[i]
        q, k, v, u = jnp.split(proj, [ATTN_WIDTH, 2 * ATTN_WIDTH, 3 * ATTN_WIDTH], axis=-1)
        attn = _neighbourhood_attention(q, k, v, q_norm_g[i], k_norm_g[i], rel_bias[i], rows)
        ssm = _s5_glu(u, ssm_lambda_re[i], ssm_lambda_im[i], ssm_log_dt[i], ssm_b_re[i],
                      ssm_b_im[i], ssm_c_re[i], ssm_c_im[i], ssm_d[i], w_glu[i])
        mixed = jnp.concatenate([_rmsnorm(attn, attn_out_g[i]), _rmsnorm(ssm, ssm_out_g[i])], axis=-1)
        x = x + g1 * (mixed @ w_out[i])

        h = _rmsnorm(x, norm2_g[i]) * (1.0 + sc2) + sh2
        x = x + g2 * (jnp.square(jax.nn.relu(h @ w_mlp1[i])) @ w_mlp2[i])
    return x
```

```cpp
#include <hip/hip_runtime.h>
#include <hip/hip_cooperative_groups.h>
#include <cstdio>
#include <cstdint>
namespace cg = cooperative_groups;

#ifndef N_LAUNCH_PER_PHASE
#define N_LAUNCH_PER_PHASE 0
#endif
#ifndef PHM
#define PHM 0xFFFFu
#endif
#define PHON(k) (((PHM) >> (k)) & 1u)
#ifndef DUP_ONLY_ATTN
#define DUP_ONLY_ATTN 0
#endif
#ifndef DUPM
#define DUPM 0u
#endif

#define LAS __attribute__((address_space(3)))
typedef unsigned short bf16_t;
typedef short bf16x8 __attribute__((ext_vector_type(8)));
typedef float f32x4 __attribute__((ext_vector_type(4)));
typedef float f32x2 __attribute__((ext_vector_type(2)));
typedef unsigned u32x4 __attribute__((ext_vector_type(4)));
typedef unsigned u32x2 __attribute__((ext_vector_type(2)));

constexpr int DM = 1024, NB = 32, SEQ = 2048, NTOK = NB * SEQ, DEPTH = 2;
constexpr int AW = 512, SW = 512, NH = 8, HD = 64, NG = 32, SG = 16, SP = 64, DFF = 4096, INC = 2048, NMOD = 6;
constexpr int CT = 32, NCH = SEQ / CT;
constexpr float EPS = 1e-6f;
constexpr float LOG2E = 1.4426950408889634f;

constexpr size_t MiB = 1u << 20;
constexpr size_t WS_MOD = 1 * MiB;
constexpr size_t WS_GM1 = 3 * MiB;
constexpr size_t WS_GM2 = WS_GM1 + 256 * 1024;
constexpr size_t WS_TBLG = WS_GM1 + 512 * 1024;
constexpr size_t WS_SHW1 = 4 * MiB;
constexpr size_t WS_SHW2 = 5 * MiB;
constexpr size_t WS_PW = 6 * MiB;
constexpr size_t WS_BBAR = 9 * MiB;
constexpr size_t WS_KT = 10 * MiB;
constexpr size_t WS_STATX = 14 * MiB;
constexpr size_t WS_STATS = 18 * MiB;
constexpr size_t WS_WQKU = 20 * MiB;
constexpr size_t WS_WV = 26 * MiB;
constexpr size_t WS_WGLU = 28 * MiB;
constexpr size_t WS_WOUT = 29 * MiB;
constexpr size_t WS_W1 = 33 * MiB;
constexpr size_t WS_W2 = 49 * MiB;
constexpr size_t WS_BT3 = 65 * MiB;
constexpr size_t WS_QS1 = 113 * MiB;
constexpr size_t WS_AX = 129 * MiB;
constexpr size_t WS_OV = 257 * MiB;
constexpr size_t WS_QB = WS_OV;
constexpr size_t WS_KB = WS_OV + 64 * MiB;
constexpr size_t WS_VT = WS_OV + 128 * MiB;
constexpr size_t WS_A3 = WS_OV + 192 * MiB;
constexpr size_t WS_LB = WS_OV + 288 * MiB;
constexpr size_t WS_Z = WS_OV + 352 * MiB;
constexpr size_t WS_MIX = WS_OV + 416 * MiB;
constexpr size_t WS_H = WS_OV;
constexpr size_t WS_END = WS_OV + 544 * MiB;
static_assert(WS_KB - WS_QB == (size_t)NTOK * AW * 2, "Kb = Qb + NTOK*AW");

namespace pg8 {
constexpr int BM = 256, BK = 64, HALF = 128, HTB = HALF * BK * 2, STAGE_BYTES = 8 * HTB, NXCD = 8, WGM = 8;
__host__ __device__ __forceinline__ int lds_byte(int r, int c) { const int st = (r >> 4) * 2 + (c >> 5), rr = r & 15, cc = c & 31, ob = rr * 64 + cc * 2; return st * 1024 + (ob ^ (((ob >> 9) & 1) << 5)); }
__host__ __device__ __forceinline__ void stage_rc(int b, int& R, int& C) { const int st = b / 1024, sb = b % 1024, swz = sb ^ (((sb >> 9) & 1) << 5); R = (st >> 1) * 16 + swz / 64; C = (st & 1) * 32 + (swz % 64) / 2; }
__host__ __device__ __forceinline__ int perm32(int rho) { const int n = rho >> 4, i = rho & 15; return 8 * (i >> 2) + 4 * n + (i & 3); }

struct Unit { int pm, pn; };
struct Gemm { const bf16_t* A; const bf16_t* Bt; int lda, ldb, K; };

struct StaticOrder {
    int nM, nN, nwg, G, c; int rev = 0;
    __device__ __forceinline__ void init(int M, int N, int G_, int c_) { nM = M / BM; nN = N / BM; nwg = nM * nN; G = G_; c = c_; }
    __device__ __forceinline__ bool next(int i, Unit& u) const {
        const long L = (long)i * G + c; if (L >= nwg) return false;
        int wgid = (int)L; { const int q = nwg / NXCD, r = nwg % NXCD, xcd = wgid % NXCD, off = wgid / NXCD; wgid = (xcd < r ? xcd * (q + 1) : r * (q + 1) + (xcd - r) * q) + off; }
        const int nig = WGM * nN, gid = wgid / nig, fm = gid * WGM, gsz = (nM - fm) < WGM ? (nM - fm) : WGM;
        u.pm = fm + ((wgid % nig) % gsz); u.pn = (wgid % nig) / gsz; if (rev) u.pm = nM - 1 - u.pm; return true;
    }
};
template <int NPG> struct GroupOrder {
    int G, c;
    __device__ __forceinline__ void init(int G_, int c_) { G = G_; c = c_; }
    __device__ __forceinline__ bool next(int i, Unit& u) const {
        const long L = (long)i * G + c; if (L >= 256 * NPG) return false;
        u.pm = (int)(L / NPG); u.pn = (u.pm >> 3) * NPG + (int)(L % NPG); return true;
    }
};
struct PairOrder {
    int G, c;
    __device__ __forceinline__ void init(int G_, int c_) { G = G_; c = c_; }
    __device__ __forceinline__ bool next(int i, Unit& u) const {
        const int pm = c + (i >> 1) * G; if (pm >= 256) return false;
        u.pm = pm; u.pn = i & 1; return true;
    }
};

typedef float cvt_f32x2_t __attribute__((ext_vector_type(2)));
typedef __bf16 cvt_bf16x2_t __attribute__((ext_vector_type(2)));
__device__ __forceinline__ unsigned cvt_pk_bf16(float lo, float hi) { const cvt_f32x2_t v = {lo, hi}; const cvt_bf16x2_t b = __builtin_convertvector(v, cvt_bf16x2_t); return __builtin_bit_cast(unsigned, b); }

template <class Epi, class Sched, bool ALIGN_EPI>
__device__ __forceinline__ void gemm_phase(LAS unsigned char* lds, const Gemm g, const Sched& S, const Epi& E) {
    int tid = threadIdx.x; asm volatile("" : "+v"(tid));
    const int wid = __builtin_amdgcn_readfirstlane(tid >> 6), lane = tid & 63, wr = wid >> 2, wc = wid & 3, fr = lane & 15, fq = lane >> 4;
    const int K = g.K, nt = K / BK;
    unsigned voffA[2], voffB[2];
#pragma unroll
    for (int i = 0; i < 2; ++i) { int R, C; stage_rc(tid * 16 + i * 8192, R, C); const int Rb = Epi::PERM ? ((R & ~31) + perm32(R & 31)) : R;
        voffA[i] = (unsigned)(R * g.lda + C) * 2u; voffB[i] = (unsigned)(Rb * g.ldb + C) * 2u; }
    const size_t kstep = (size_t)(BK * 2);
    const size_t hstepA = (size_t)HALF * g.lda * 2, hstepB = (size_t)HALF * g.ldb * 2;
    const size_t tstepA = 2 * hstepA, tstepB = 2 * hstepB;
    const unsigned ldsw = (unsigned)wid * 1024u;
    const int aoff = lds_byte(wr * 64 + fr, fq * 8), boff = lds_byte(wc * 32 + fr, fq * 8);
#define PG8_SA(b, h) (((b) * 2 + (h)) * HTB)
#define PG8_SB(b, h) ((4 + (b) * 2 + (h)) * HTB)
#define PG8_STAGE(bufoff, gbase, voff) do { _Pragma("unroll") for (int _i = 0; _i < 2; ++_i) \
        __builtin_amdgcn_global_load_lds((const unsigned*)((const char*)(gbase) + (voff)[_i]), (LAS unsigned*)(lds + (bufoff) + ldsw + _i * 8192), 16, 0, 0); } while (0)
#define PG8_LDA(dst, b, h) do { _Pragma("unroll") for (int m = 0; m < 4; ++m) _Pragma("unroll") for (int k = 0; k < 2; ++k) dst[m][k] = *(const LAS bf16x8*)(lds + PG8_SA(b, h) + aoff + m * 2048 + k * 1024); } while (0)
#define PG8_LDB(dst, b, h) do { _Pragma("unroll") for (int n = 0; n < 2; ++n) _Pragma("unroll") for (int k = 0; k < 2; ++k) dst[n][k] = *(const LAS bf16x8*)(lds + PG8_SB(b, h) + boff + n * 2048 + k * 1024); } while (0)
#define PG8_MMA(ai, bj, At, Bt) do { __builtin_amdgcn_s_setprio(1); _Pragma("unroll") for (int m = 0; m < 4; ++m) _Pragma("unroll") for (int n = 0; n < 2; ++n) _Pragma("unroll") for (int k = 0; k < 2; ++k) \
        acc[ai][bj][m][n] = __builtin_amdgcn_mfma_f32_16x16x32_bf16(Bt[n][k], At[m][k], acc[ai][bj][m][n], 0, 0, 0); __builtin_amdgcn_s_setprio(0); } while (0)
#define PG8_WAIT_V(n) asm volatile("s_waitcnt vmcnt(" #n ")" ::: "memory")
#define PG8_WAIT_L(n) asm volatile("s_waitcnt lgkmcnt(" #n ")" ::: "memory")
#define PG8_BAR __builtin_amdgcn_s_barrier()
#define PG8_SCHED __builtin_amdgcn_sched_barrier(0)
    Unit cur, nxt; int ui = 0;
    if (!S.next(0, cur)) return;
    f32x4 acc[2][2][4][2];
#pragma unroll
    for (int a = 0; a < 2; ++a)
#pragma unroll
        for (int b = 0; b < 2; ++b)
#pragma unroll
            for (int m = 0; m < 4; ++m)
#pragma unroll
                for (int n = 0; n < 2; ++n) acc[a][b][m][n] = (f32x4){0.f, 0.f, 0.f, 0.f};
    bf16x8 At[4][2], B0[2][2], B1[2][2];
    const char* cA = (const char*)g.A + (size_t)cur.pm * tstepA; const char* cB = (const char*)g.Bt + (size_t)cur.pn * tstepB;
    PG8_STAGE(PG8_SB(0, 0), cB, voffB); PG8_STAGE(PG8_SB(0, 1), cB + hstepB, voffB); PG8_STAGE(PG8_SA(0, 0), cA, voffA); PG8_STAGE(PG8_SA(0, 1), cA + hstepA, voffA);
    if (wr == 1) PG8_BAR;
    PG8_WAIT_V(2); PG8_BAR;
    PG8_STAGE(PG8_SB(1, 0), cB + kstep, voffB); PG8_STAGE(PG8_SA(1, 0), cA + kstep, voffA); PG8_STAGE(PG8_SB(1, 1), cB + hstepB + kstep, voffB);
    PG8_WAIT_V(6); PG8_BAR;
    for (;;) {
        const bool has_next = S.next(ui + 1, nxt);
        const char* nA = has_next ? (const char*)g.A + (size_t)nxt.pm * tstepA : cA; const char* nB = has_next ? (const char*)g.Bt + (size_t)nxt.pn * tstepB : cB;
        for (int t = 0; t < nt; t += 2) {
            const bool last = (t == nt - 2);
            const char* a1 = cA + (size_t)(t + 1) * kstep;
            const char* a2 = last ? nA : cA + (size_t)(t + 2) * kstep; const char* b2 = last ? nB : cB + (size_t)(t + 2) * kstep;
            const char* a3 = a2 + kstep; const char* b3 = b2 + kstep;
            PG8_LDB(B0, 0, 0); PG8_LDB(B1, 0, 1); PG8_SCHED; PG8_LDA(At, 0, 0); PG8_STAGE(PG8_SA(1, 1), a1 + hstepA, voffA);
            PG8_WAIT_V(8); PG8_WAIT_L(0); PG8_BAR; PG8_MMA(0, 0, At, B0); PG8_MMA(0, 1, At, B1); PG8_BAR; PG8_SCHED;
            PG8_LDA(At, 0, 1); PG8_STAGE(PG8_SB(0, 0), b2, voffB); PG8_STAGE(PG8_SB(0, 1), b2 + hstepB, voffB); PG8_STAGE(PG8_SA(0, 0), a2, voffA);
            PG8_WAIT_V(8); PG8_WAIT_L(0); PG8_BAR; PG8_MMA(1, 0, At, B0); PG8_MMA(1, 1, At, B1); PG8_BAR; PG8_SCHED;
            PG8_LDB(B0, 1, 0); PG8_LDB(B1, 1, 1); PG8_SCHED; PG8_LDA(At, 1, 0); PG8_STAGE(PG8_SA(0, 1), a2 + hstepA, voffA);
            PG8_WAIT_V(8); PG8_WAIT_L(0); PG8_BAR; PG8_MMA(0, 0, At, B0); PG8_MMA(0, 1, At, B1); PG8_BAR; PG8_SCHED;
            PG8_LDA(At, 1, 1); PG8_STAGE(PG8_SB(1, 0), b3, voffB); PG8_STAGE(PG8_SB(1, 1), b3 + hstepB, voffB); PG8_STAGE(PG8_SA(1, 0), a3, voffA);
            PG8_WAIT_V(8); PG8_WAIT_L(0); PG8_BAR; PG8_MMA(1, 0, At, B0); PG8_MMA(1, 1, At, B1); PG8_BAR; PG8_SCHED;
        }
        if constexpr (ALIGN_EPI) { if (wr == 0) PG8_BAR; }
        if constexpr (!Epi::AFTER_DRAIN) { int fr_e = fr, fq_e = fq; asm volatile("" : "+v"(fr_e), "+v"(fq_e));
          E(acc, cur, wr, wc, fr_e, fq_e); }
        if (!has_next) break;
#pragma unroll
        for (int a = 0; a < 2; ++a)
#pragma unroll
            for (int b = 0; b < 2; ++b)
#pragma unroll
                for (int m = 0; m < 4; ++m)
#pragma unroll
                    for (int n = 0; n < 2; ++n) acc[a][b][m][n] = (f32x4){0.f, 0.f, 0.f, 0.f};
        cur = nxt; cA = nA; cB = nB; ++ui;
        if constexpr (ALIGN_EPI) { if (wr == 1) PG8_BAR; }
    }
    PG8_WAIT_V(0);
    if constexpr (!ALIGN_EPI) { if (wr == 0) PG8_BAR; }
    PG8_BAR;
    if constexpr (Epi::AFTER_DRAIN) E.fused(acc, cur, wr, wc, fr, fq, lds, tid);
#undef PG8_SA
#undef PG8_SB
#undef PG8_STAGE
#undef PG8_LDA
#undef PG8_LDB
#undef PG8_MMA
#undef PG8_WAIT_V
#undef PG8_WAIT_L
#undef PG8_BAR
#undef PG8_SCHED
}
}
using pg8::Unit; using pg8::cvt_pk_bf16;

__device__ __forceinline__ unsigned f2bf(float f);
__device__ __forceinline__ float bf_lo(unsigned u) { return __uint_as_float(u << 16); }
__device__ __forceinline__ float bf_hi(unsigned u) { return __uint_as_float(u & 0xffff0000u); }
__device__ __forceinline__ float rsq(float x) { return __builtin_amdgcn_rsqf(x); }
__device__ __forceinline__ float rcpf_(float x) { return __builtin_amdgcn_rcpf(x); }
__device__ __forceinline__ float sum4(f32x4 v) { return (v[0] + v[1]) + (v[2] + v[3]); }
__device__ __forceinline__ float sq4(f32x4 v) { return (v[0] * v[0] + v[1] * v[1]) + (v[2] * v[2] + v[3] * v[3]); }
__device__ __forceinline__ float sigmoidf_(float x) { return __builtin_amdgcn_rcpf(1.0f + __builtin_amdgcn_exp2f(-LOG2E * x)); }

__device__ __forceinline__ float row_rstd16(const float* statx, int row) {
    const f32x4* p = (const f32x4*)(statx + (size_t)row * 16);
    const f32x4 a = p[0], b = p[1], c = p[2], d = p[3];
    return rsq(((sum4(a) + sum4(b)) + (sum4(c) + sum4(d))) * (1.0f / DM) + EPS);
}

__device__ __forceinline__ void tile_rstd_to_lds(const float* statx, int row0, LAS float* rsl, int wr, int wc, int fr, int fq) {
    const int t = (wr * 4 + wc) * 64 + fq * 16 + fr;
    if (t < 256) rsl[t] = row_rstd16(statx, row0 + t);
    asm volatile("s_waitcnt lgkmcnt(0)" ::: "memory"); __builtin_amdgcn_s_barrier(); asm volatile("" ::: "memory");
}
struct EpiIn {
    static constexpr bool PERM = true; static constexpr bool AFTER_DRAIN = false;
    const float* statx; const float* shw;
    const float* gq; const float* gk;
    bf16_t* Qb; bf16_t* A3; LAS float* rsl;
    __device__ __forceinline__ void operator()(const f32x4 (&acc)[2][2][4][2], const Unit& u, int wr, int wc, int fr, int fq) const {
        const int b = u.pm >> 3, pn = u.pn;
        const int ncol0 = (pn < 4 ? 256 * pn : 1536 + 256 * (pn - 4)) + 64 * wc + 8 * fq;
        f32x4 sw[2][2];
#pragma unroll
        for (int bj = 0; bj < 2; ++bj)
#pragma unroll
            for (int n = 0; n < 2; ++n) sw[bj][n] = *(const f32x4*)(shw + (size_t)b * INC + ncol0 + 32 * bj + 4 * n);
        tile_rstd_to_lds(statx, u.pm * 256, rsl, wr, wc, fr, fq);
#pragma unroll
        for (int ai = 0; ai < 2; ++ai) {
#pragma unroll
            for (int m = 0; m < 4; ++m) {
                const int row = u.pm * 256 + ai * 128 + wr * 64 + m * 16 + fr;
                const float rs = rsl[ai * 128 + wr * 64 + m * 16 + fr];
                f32x4 v[2][2]; float ss = 0.f;
#pragma unroll
                for (int bj = 0; bj < 2; ++bj)
#pragma unroll
                    for (int n = 0; n < 2; ++n) { v[bj][n] = acc[ai][bj][m][n] * rs + sw[bj][n]; ss += sq4(v[bj][n]); }
                if (pn < 4) {
                    ss += __shfl_xor(ss, 16); ss += __shfl_xor(ss, 32);
                    const float hr = rsq(ss * (1.0f / HD) + EPS);
                    const int rrow = (u.pm & 7) * 4 + ai * 2 + wr, head = 4 * (pn & 1) + wc;
                    size_t fbase;
                    if (pn < 2) fbase = ((((size_t)(b * 32 + rrow) * 8 + head) * 4 + m) * 2) * 512 + (size_t)(fq * 16 + fr) * 8;
                    else { const int kb = m >> 1, kt = (fr >> 2) & 1, frk = ((2 * (m & 1) + (fr >> 3)) << 2) | (fr & 3);
                        fbase = (size_t)NTOK * AW + ((((((size_t)(b * 32 + rrow) * 8 + head) * 2 + kb) * 2 + kt) * 2) * 512) + (size_t)(fq * 16 + frk) * 8; }
                    bf16_t* dst = Qb + fbase;
#pragma unroll
                    for (int bj = 0; bj < 2; ++bj) {
                        f32x4 a = v[bj][0] * hr, c = v[bj][1] * hr;
                        if (pn < 2) { const int d = 32 * bj + 8 * fq; a = a * (*(const f32x4*)(gq + d) * *(const f32x4*)(gk + d) * (0.125f * LOG2E)); c = c * (*(const f32x4*)(gq + d + 4) * *(const f32x4*)(gk + d + 4) * (0.125f * LOG2E)); }
                        u32x4 w; w.x = cvt_pk_bf16(a[0], a[1]); w.y = cvt_pk_bf16(a[2], a[3]); w.z = cvt_pk_bf16(c[0], c[1]); w.w = cvt_pk_bf16(c[2], c[3]);
                        *(u32x4*)(dst + 512 * bj) = w;
                    }
                } else {
                    const int tl = row & (SEQ - 1), ch = tl >> 5, s = tl & 31;
#pragma unroll
                    for (int bj = 0; bj < 2; ++bj) {
                        const int cu = 256 * (pn - 4) + 64 * wc + 32 * bj + 8 * fq;
                        const int gidx = cu >> 4, half = (cu >> 3) & 1;
                        bf16_t* dst = A3 + ((size_t)gidx * 2048 + b * NCH + ch) * 768 + s * 16 + 8 * half;
                        u32x4 w; w.x = cvt_pk_bf16(v[bj][0][0], v[bj][0][1]); w.y = cvt_pk_bf16(v[bj][0][2], v[bj][0][3]); w.z = cvt_pk_bf16(v[bj][1][0], v[bj][1][1]); w.w = cvt_pk_bf16(v[bj][1][2], v[bj][1][3]);
                        *(u32x4*)dst = w;
                    }
                }
            }
        }
    }
};
struct EpiVt {
    static constexpr bool PERM = true; static constexpr bool AFTER_DRAIN = false;
    const float* statx; const float* shw; bf16_t* VT; LAS float* rsl;
    __device__ __forceinline__ void operator()(const f32x4 (&acc)[2][2][4][2], const Unit& u, int wr, int wc, int fr, int fq) const {
        const int b = u.pn >> 3, t0 = (u.pn & 7) * 256 + wc * 32 + 8 * fq;
        tile_rstd_to_lds(statx, u.pn * 256, rsl, wr, wc, fr, fq);
        float rs[2][8];
#pragma unroll
        for (int bj = 0; bj < 2; ++bj) { const f32x4 r0_ = *(const LAS f32x4*)(rsl + 128 * bj + wc * 32 + 8 * fq), r1_ = *(const LAS f32x4*)(rsl + 128 * bj + wc * 32 + 8 * fq + 4);
            rs[bj][0] = r0_[0]; rs[bj][1] = r0_[1]; rs[bj][2] = r0_[2]; rs[bj][3] = r0_[3]; rs[bj][4] = r1_[0]; rs[bj][5] = r1_[1]; rs[bj][6] = r1_[2]; rs[bj][7] = r1_[3]; }
#pragma unroll
        for (int ai = 0; ai < 2; ++ai)
#pragma unroll
            for (int m = 0; m < 4; ++m) {
                const int cv = u.pm * 256 + ai * 128 + wr * 64 + m * 16 + fr;
                const float sh = shw[(size_t)b * INC + 1024 + cv];
                const int head = u.pm * 4 + ai * 2 + wr;
#pragma unroll
                for (int bj = 0; bj < 2; ++bj) {
                    const int rrow = (u.pn & 7) * 4 + bj * 2 + (wc >> 1), kb = wc & 1;
                    bf16_t* dst = VT + (((((size_t)(b * 32 + rrow) * 8 + head) * 2 + kb) * 4 + m) * 512) + (size_t)(fq * 16 + fr) * 8;
                    const f32x4 a = acc[ai][bj][m][0], c = acc[ai][bj][m][1];
                    u32x4 w; w.x = cvt_pk_bf16(a[0] * rs[bj][0] + sh, a[1] * rs[bj][1] + sh); w.y = cvt_pk_bf16(a[2] * rs[bj][2] + sh, a[3] * rs[bj][3] + sh);
                    w.z = cvt_pk_bf16(c[0] * rs[bj][4] + sh, c[1] * rs[bj][5] + sh); w.w = cvt_pk_bf16(c[2] * rs[bj][6] + sh, c[3] * rs[bj][7] + sh);
                    *(u32x4*)dst = w;
                }
            }
    }
};
struct EpiS1 {
    static constexpr bool PERM = false; static constexpr bool AFTER_DRAIN = false;
    float* L;
    __device__ __forceinline__ void operator()(const f32x4 (&acc)[2][2][4][2], const Unit& u, int wr, int wc, int fr, int fq) const {
#pragma unroll
        for (int ai = 0; ai < 2; ++ai)
#pragma unroll
            for (int m = 0; m < 4; ++m) {
                float* rowp = L + (size_t)(u.pm * 256 + ai * 128 + wr * 64 + m * 16 + fr) * 256 + wc * 32 + 4 * fq;
#pragma unroll
                for (int bj = 0; bj < 2; ++bj)
#pragma unroll
                    for (int n = 0; n < 2; ++n) *(f32x4*)(rowp + 128 * bj + 16 * n) = acc[ai][bj][m][n];
            }
    }
};
struct EpiS1F {
    static constexpr bool PERM = false; static constexpr bool AFTER_DRAIN = true;
    const f32x2* pwl;
    bf16_t* A3;
    __device__ __forceinline__ void operator()(const f32x4 (&)[2][2][4][2], const Unit&, int, int, int, int) const {}
    __device__ __forceinline__ void fused(const f32x4 (&acc)[2][2][4][2], const Unit& u, int wr, int wc, int fr, int fq, LAS unsigned char* lds, int tid) const {
        LAS float* T = (LAS float*)lds;
        const int gi = u.pm >> 3;
#pragma unroll
        for (int half = 0; half < 2; ++half) {
#pragma unroll
            for (int m = 0; m < 4; ++m)
#pragma unroll
                for (int bj = 0; bj < 2; ++bj)
#pragma unroll
                    for (int n = 0; n < 2; ++n) *(LAS f32x4*)(T + (wr * 64 + m * 16 + fr) * 260 + 128 * bj + 32 * wc + 16 * n + 4 * fq) = acc[half][bj][m][n];
            asm volatile("s_waitcnt lgkmcnt(0)" ::: "memory"); __builtin_amdgcn_s_barrier(); asm volatile("" ::: "memory");
            if (tid < 256) {
                const int bb = tid >> 7, dir = (tid >> 6) & 1, p = tid & 63, b = 4 * (u.pm & 7) + 2 * half + bb;
                const f32x2 w = pwl[((size_t)(dir * 32 + gi) * 33 + 32) * 64 + p];
                float hr = 0.f, hi_ = 0.f;
                bf16_t* abase = A3 + ((size_t)gi * 2048 + b * NCH) * 768 + 512 + dir * 128 + p;
                const LAS float* tb_ = T + (bb * 64) * 260 + dir * 128 + p;
#pragma unroll 8
                for (int cc = 0; cc < NCH; ++cc) { const int ch = dir == 0 ? cc : NCH - 1 - cc;
                    bf16_t* ap = abase + (size_t)ch * 768; ap[0] = (bf16_t)f2bf(hr); ap[64] = (bf16_t)f2bf(hi_);
                    const float lr = tb_[ch * 260], li = tb_[ch * 260 + 64];
                    const float nr = w.x * hr - w.y * hi_ + lr, ni = w.x * hi_ + w.y * hr + li; hr = nr; hi_ = ni; }
            }
            asm volatile("s_waitcnt lgkmcnt(0)" ::: "memory"); __builtin_amdgcn_s_barrier(); asm volatile("" ::: "memory");
        }
    }
};
__device__ __forceinline__ float gelu_tanh(float y) {
    const float t = 1.5957691216057308f * (y + 0.044715f * y * y * y);
    return y * __builtin_amdgcn_rcpf(1.0f + __builtin_amdgcn_exp2f(-LOG2E * t));
}
struct EpiS3 {
    static constexpr bool PERM = true; static constexpr bool AFTER_DRAIN = false;
    bf16_t* Z;
    __device__ __forceinline__ void operator()(const f32x4 (&acc)[2][2][4][2], const Unit& u, int wr, int wc, int fr, int fq) const {
        const int gidx = u.pm >> 3;
#pragma unroll
        for (int ai = 0; ai < 2; ++ai)
#pragma unroll
            for (int m = 0; m < 4; ++m) {
                const int bc = (u.pm & 7) * 256 + ai * 128 + wr * 64 + m * 16 + fr, b = bc >> 6, ch = bc & 63;
#pragma unroll
                for (int bj = 0; bj < 2; ++bj) {
                    const int nl = (u.pn & 1) * 256 + bj * 128 + wc * 32 + 8 * fq, tau = nl >> 4, c8 = nl & 15;
                    const f32x4 a = acc[ai][bj][m][0], c = acc[ai][bj][m][1];
                    u32x4 w; w.x = cvt_pk_bf16(gelu_tanh(a[0]), gelu_tanh(a[1])); w.y = cvt_pk_bf16(gelu_tanh(a[2]), gelu_tanh(a[3]));
                    w.z = cvt_pk_bf16(gelu_tanh(c[0]), gelu_tanh(c[1])); w.w = cvt_pk_bf16(gelu_tanh(c[2]), gelu_tanh(c[3]));
                    *(u32x4*)(Z + (size_t)(b * SEQ + ch * CT + tau) * SW + gidx * 16 + c8) = w;
                }
            }
    }
};
struct EpiGlu {
    static constexpr bool PERM = true; static constexpr bool AFTER_DRAIN = false;
    const bf16_t* Z; const float* gs; float* stats; bf16_t* MIX;
    __device__ __forceinline__ void operator()(const f32x4 (&acc)[2][2][4][2], const Unit& u, int wr, int wc, int fr, int fq) const {
        const int col0 = u.pn * 256 + wc * 32 + 8 * fq;
        f32x4 gv[2][2];
#pragma unroll
        for (int bj = 0; bj < 2; ++bj)
#pragma unroll
            for (int n = 0; n < 2; ++n) gv[bj][n] = *(const f32x4*)(gs + col0 + 128 * bj + 4 * n);
#pragma unroll
        for (int ai = 0; ai < 2; ++ai) {
            u32x4 zpre[4][2];
#pragma unroll
            for (int m = 0; m < 4; ++m)
#pragma unroll
                for (int bj = 0; bj < 2; ++bj) zpre[m][bj] = *(const u32x4*)(Z + (size_t)(u.pm * 256 + ai * 128 + wr * 64 + m * 16 + fr) * SW + col0 + 128 * bj);
            asm volatile("" ::: "memory");
#pragma unroll
            for (int m = 0; m < 4; ++m) {
                const int row = u.pm * 256 + ai * 128 + wr * 64 + m * 16 + fr;
                float ss = 0.f;
#pragma unroll
                for (int bj = 0; bj < 2; ++bj) {
                    const u32x4 zz = zpre[m][bj];
                    const f32x4 a = acc[ai][bj][m][0], c = acc[ai][bj][m][1];
                    f32x4 o0, o1;
                    o0[0] = bf_lo(zz.x) * sigmoidf_(a[0]); o0[1] = bf_hi(zz.x) * sigmoidf_(a[1]); o0[2] = bf_lo(zz.y) * sigmoidf_(a[2]); o0[3] = bf_hi(zz.y) * sigmoidf_(a[3]);
                    o1[0] = bf_lo(zz.z) * sigmoidf_(c[0]); o1[1] = bf_hi(zz.z) * sigmoidf_(c[1]); o1[2] = bf_lo(zz.w) * sigmoidf_(c[2]); o1[3] = bf_hi(zz.w) * sigmoidf_(c[3]);
                    ss += sq4(o0) + sq4(o1);
                    o0 = o0 * gv[bj][0]; o1 = o1 * gv[bj][1];
                    u32x4 w; w.x = cvt_pk_bf16(o0[0], o0[1]); w.y = cvt_pk_bf16(o0[2], o0[3]); w.z = cvt_pk_bf16(o1[0], o1[1]); w.w = cvt_pk_bf16(o1[2], o1[3]);
                    *(u32x4*)(MIX + (size_t)row * DM + AW + col0 + 128 * bj) = w;
                }
                ss += __shfl_xor(ss, 16); ss += __shfl_xor(ss, 32);
                if (fq == 0) stats[(size_t)row * 8 + u.pn * 4 + wc] = ss;
            }
        }
    }
};
struct EpiRes {
    static constexpr bool PERM = true; static constexpr bool AFTER_DRAIN = false;
    const float* xin; float* xout; const float* gate; int gate_ld;
    const float* gmn; bf16_t* AX; float* statx;
    LAS float* gl; int nt;
    __device__ __forceinline__ void operator()(const f32x4 (&acc)[2][2][4][2], const Unit& u, int wr, int wc, int fr, int fq) const {
        const int b = u.pm >> 3, col0 = u.pn * 256 + wc * 32 + 8 * fq;
        { const int t = (wr * 4 + wc) * 64 + fq * 16 + fr;
          if (t < 64) ((LAS f32x4*)gl)[t] = *(const f32x4*)(gate + (size_t)b * gate_ld + u.pn * 256 + 4 * t);
          else if (t < 128 && gmn) ((LAS f32x4*)gl)[t] = *(const f32x4*)(gmn + (size_t)b * DM + u.pn * 256 + 4 * (t - 64));
          asm volatile("s_waitcnt vmcnt(0) lgkmcnt(0)" ::: "memory"); __builtin_amdgcn_s_barrier(); asm volatile("" ::: "memory"); }
        const LAS float* gtp = gl + wc * 32 + 8 * fq; const LAS float* gmp = gl + 256 + wc * 32 + 8 * fq;
#pragma unroll
        for (int ai = 0; ai < 2; ++ai) {
            f32x4 xr[4][2][2];
#pragma unroll
            for (int m = 0; m < 4; ++m) { const size_t off = (size_t)(u.pm * 256 + ai * 128 + wr * 64 + m * 16 + fr) * DM + col0;
#pragma unroll
                for (int bj = 0; bj < 2; ++bj)
#pragma unroll
                    for (int n = 0; n < 2; ++n) xr[m][bj][n] = nt ? __builtin_nontemporal_load((const f32x4*)(xin + off + 128 * bj + 4 * n)) : *(const f32x4*)(xin + off + 128 * bj + 4 * n); }
            asm volatile("" ::: "memory");
#pragma unroll
            for (int m = 0; m < 4; ++m) {
                const int row = u.pm * 256 + ai * 128 + wr * 64 + m * 16 + fr;
                const size_t off = (size_t)row * DM + col0;
                float ss = 0.f;
#pragma unroll
                for (int bj = 0; bj < 2; ++bj) {
                    const f32x4 xo0 = xr[m][bj][0] + *(const LAS f32x4*)(gtp + 128 * bj) * acc[ai][bj][m][0], xo1 = xr[m][bj][1] + *(const LAS f32x4*)(gtp + 128 * bj + 4) * acc[ai][bj][m][1];
                    if (nt) { __builtin_nontemporal_store(xo0, (f32x4*)(xout + off + 128 * bj)); __builtin_nontemporal_store(xo1, (f32x4*)(xout + off + 128 * bj + 4)); } else { *(f32x4*)(xout + off + 128 * bj) = xo0; *(f32x4*)(xout + off + 128 * bj + 4) = xo1; }
                    if (gmn) { ss += sq4(xo0) + sq4(xo1); const f32x4 a = xo0 * *(const LAS f32x4*)(gmp + 128 * bj), c = xo1 * *(const LAS f32x4*)(gmp + 128 * bj + 4);
                        u32x4 w; w.x = cvt_pk_bf16(a[0], a[1]); w.y = cvt_pk_bf16(a[2], a[3]); w.z = cvt_pk_bf16(c[0], c[1]); w.w = cvt_pk_bf16(c[2], c[3]); *(u32x4*)(AX + off + 128 * bj) = w; }
                }
                if (gmn) { ss += __shfl_xor(ss, 16); ss += __shfl_xor(ss, 32); if (fq == 0) statx[(size_t)row * 16 + u.pn * 4 + wc] = ss; }
            }
        }
    }
};
struct EpiMlp1 {
    static constexpr bool PERM = true; static constexpr bool AFTER_DRAIN = false;
    const float* statx; const float* shw; bf16_t* H; LAS float* rsl;
    __device__ __forceinline__ void operator()(const f32x4 (&acc)[2][2][4][2], const Unit& u, int wr, int wc, int fr, int fq) const {
        const int b = u.pm >> 3, col0 = u.pn * 256 + wc * 32 + 8 * fq;
        f32x4 sw[2][2];
#pragma unroll
        for (int bj = 0; bj < 2; ++bj)
#pragma unroll
            for (int n = 0; n < 2; ++n) sw[bj][n] = *(const f32x4*)(shw + (size_t)b * DFF + col0 + 128 * bj + 4 * n);
        tile_rstd_to_lds(statx, u.pm * 256, rsl, wr, wc, fr, fq);
#pragma unroll
        for (int ai = 0; ai < 2; ++ai)
#pragma unroll
            for (int m = 0; m < 4; ++m) {
                const int row = u.pm * 256 + ai * 128 + wr * 64 + m * 16 + fr;
                const float rs = rsl[ai * 128 + wr * 64 + m * 16 + fr];
#pragma unroll
                for (int bj = 0; bj < 2; ++bj) {
                    f32x4 a = acc[ai][bj][m][0] * rs + sw[bj][0], c = acc[ai][bj][m][1] * rs + sw[bj][1];
#pragma unroll
                    for (int e = 0; e < 4; ++e) { a[e] = fmaxf(a[e], 0.f); a[e] *= a[e]; c[e] = fmaxf(c[e], 0.f); c[e] *= c[e]; }
                    u32x4 w; w.x = cvt_pk_bf16(a[0], a[1]); w.y = cvt_pk_bf16(a[2], a[3]); w.z = cvt_pk_bf16(c[0], c[1]); w.w = cvt_pk_bf16(c[2], c[3]);
                    *(u32x4*)(H + (size_t)row * DFF + col0 + 128 * bj) = w;
                }
            }
    }
};

struct Args { const float* in[24]; float* out; unsigned char* ws; int ph_lo, ph_hi; };
constexpr int LDS_BYTES = 147456;
constexpr int NPH = 3 + 8 * DEPTH;

__device__ __forceinline__ float wave_sum(float v) {
#pragma unroll
    for (int o = 1; o < 64; o <<= 1) v += __shfl_xor(v, o);
    return v;
}
__device__ __forceinline__ unsigned f2bf(float f) { unsigned u = __float_as_uint(f); return (u + 0x7fffu + ((u >> 16) & 1u)) >> 16; }
__device__ __forceinline__ unsigned pk2(float lo, float hi) { return f2bf(lo) | (f2bf(hi) << 16); }

__device__ __forceinline__ void transpose_item(const float* W, int N, int ksrc0, int nsrc0, bf16_t* WT, int ldt, int drow0, int kdst0, LAS float* scr, int lane) {
    float tv[32];
#pragma unroll
    for (int i = 0; i < 32; ++i) { const int kk = 2 * i + (lane >> 5); tv[i] = W[(size_t)(ksrc0 + kk) * N + nsrc0 + (lane & 31)]; }
#pragma unroll
    for (int i = 0; i < 32; ++i) { const int kk = 2 * i + (lane >> 5); scr[kk * 33 + (lane & 31)] = tv[i]; }
    asm volatile("s_waitcnt lgkmcnt(0)" ::: "memory");
    const int c = lane & 7;
#pragma unroll
    for (int j = 0; j < 4; ++j) { const int n = (lane >> 3) + 8 * j; const LAS float* s = scr + (8 * c) * 33 + n;
        u32x4 o; o.x = pk2(s[0 * 33], s[1 * 33]); o.y = pk2(s[2 * 33], s[3 * 33]); o.z = pk2(s[4 * 33], s[5 * 33]); o.w = pk2(s[6 * 33], s[7 * 33]);
        *(u32x4*)(WT + (size_t)(drow0 + n) * ldt + kdst0 + 8 * c) = o; }
    asm volatile("s_waitcnt lgkmcnt(0)" ::: "memory");
}

typedef float f32x16 __attribute__((ext_vector_type(16)));
constexpr int S16_LD = 1032;
__device__ __forceinline__ void gemv32_task(LAS unsigned char* ldsb, const float* W, int N, int col0, const float* bias, float* out, int out_ld, int tid) {
    const int wave = tid >> 6, lane = tid & 63, n = lane & 31, kh = lane >> 5;
    const LAS bf16_t* S16 = (const LAS bf16_t*)ldsb;
    f32x16 acc0, acc1;
#pragma unroll
    for (int e = 0; e < 16; ++e) { acc0[e] = 0.f; acc1[e] = 0.f; }
    const float* wp = W + (size_t)(wave * 128 + 8 * kh) * N + col0 + n;
#pragma unroll 1
    for (int ks = 0; ks < 8; ks += 2) {
        float w0[2][8], w1[2][8];
#pragma unroll
        for (int q = 0; q < 2; ++q)
#pragma unroll
            for (int j = 0; j < 8; ++j) { w0[q][j] = wp[(size_t)((ks + q) * 16 + j) * N]; w1[q][j] = wp[(size_t)((ks + q) * 16 + j) * N + 32]; }
#pragma unroll
        for (int q = 0; q < 2; ++q) {
            const bf16x8 a = *(const LAS bf16x8*)(S16 + n * S16_LD + wave * 128 + (ks + q) * 16 + 8 * kh);
            union { u32x4 u; bf16x8 v; } b0, b1;
            b0.u.x = pk2(w0[q][0], w0[q][1]); b0.u.y = pk2(w0[q][2], w0[q][3]); b0.u.z = pk2(w0[q][4], w0[q][5]); b0.u.w = pk2(w0[q][6], w0[q][7]);
            b1.u.x = pk2(w1[q][0], w1[q][1]); b1.u.y = pk2(w1[q][2], w1[q][3]); b1.u.z = pk2(w1[q][4], w1[q][5]); b1.u.w = pk2(w1[q][6], w1[q][7]);
            acc0 = __builtin_amdgcn_mfma_f32_32x32x16_bf16(a, b0.v, acc0, 0, 0, 0);
            acc1 = __builtin_amdgcn_mfma_f32_32x32x16_bf16(a, b1.v, acc1, 0, 0, 0);
        }
    }
    __syncthreads();
    LAS float* red = (LAS float*)ldsb;
#pragma unroll
    for (int e = 0; e < 16; ++e) { const int row = (e & 3) + 8 * (e >> 2) + 4 * kh;
        red[(wave * 32 + row) * 64 + n] = acc0[e]; red[(wave * 32 + row) * 64 + 32 + n] = acc1[e]; }
    __syncthreads();
    for (int o = tid; o < 2048; o += 512) { const int b = o >> 6, l = o & 63; float s = bias ? bias[col0 + l] : 0.f;
#pragma unroll
        for (int w = 0; w < 8; ++w) s += red[(w * 32 + b) * 64 + l];
        out[(size_t)b * out_ld + col0 + l] = s; }
    __syncthreads();
}

__device__ __forceinline__ void dsincos_red(double x, double& s, double& c) {
    const double TWO_PI = 6.283185307179586476925, INV = 0.15915494309189533577;
    const double k = rint(x * INV); x = x - k * TWO_PI;
    const double x2 = x * x; double ts = 1.0, tc = 1.0;
#pragma unroll 1
    for (int n = 31; n >= 3; n -= 2) { ts = 1.0 - ts * x2 / (double)(n * (n - 1)); }
#pragma unroll 1
    for (int n = 30; n >= 2; n -= 2) { tc = 1.0 - tc * x2 / (double)(n * (n - 1)); }
    s = x * ts; c = tc;
}
__device__ __forceinline__ double dexp_small(double x) { double t = 1.0;
#pragma unroll 1
    for (int n = 14; n >= 1; --n) t = 1.0 + t * x / (double)n;
    return t; }

__device__ __forceinline__ void attn_phase(LAS unsigned char* lds, const bf16_t* Qb, const bf16_t* Kb, const bf16_t* VT, bf16_t* MIX,
                                           const float* tblg, const float* ga) {
    int tid = threadIdx.x; asm volatile("" : "+v"(tid));
    const int h = __builtin_amdgcn_readfirstlane(tid >> 6), lane = tid & 63, fr = lane & 15, fq = lane >> 4;
    LAS float* tbl = (LAS float*)lds;
    LAS float* red = (LAS float*)(lds + 61440);
#pragma unroll
    for (int i4 = 0; i4 < 8; ++i4) { const int i = tid + 512 * i4; if (i < NH * 15 * 128 / 4) ((LAS f32x4*)tbl)[i] = ((const f32x4*)tblg)[i]; }
    __syncthreads();
    LAS u32x4* mskl = (LAS u32x4*)(lds + 63488);
    if (h == 0) {
#pragma unroll
        for (int qt = 0; qt < 4; ++qt)
#pragma unroll
            for (int kb = 0; kb < 2; ++kb) {
                if ((qt == 0 && kb == 1) || (qt == 3 && kb == 0)) continue;
                const int bi = qt == 0 ? 0 : (qt == 1 ? 1 + kb : (qt == 2 ? 3 + kb : 5));
                const int qc = 16 * qt + fr, cs = min(max(qc - 8, 0), 48), d = 32 * kb + 8 * fq - cs;
                u32x4 mm;
                mm.x = (((unsigned)(d + 0) < 16u) ? 0xffffu : 0u) | (((unsigned)(d + 1) < 16u) ? 0xffff0000u : 0u);
                mm.y = (((unsigned)(d + 2) < 16u) ? 0xffffu : 0u) | (((unsigned)(d + 3) < 16u) ? 0xffff0000u : 0u);
                mm.z = (((unsigned)(d + 4) < 16u) ? 0xffffu : 0u) | (((unsigned)(d + 5) < 16u) ? 0xffff0000u : 0u);
                mm.w = (((unsigned)(d + 6) < 16u) ? 0xffffu : 0u) | (((unsigned)(d + 7) < 16u) ? 0xffff0000u : 0u);
                mskl[bi * 64 + lane] = mm;
            }
    }
    __syncthreads();
    const bool xmap = (gridDim.x == 256);
    for (int ui = 0, unit = blockIdx.x; unit < NB * 32; unit += gridDim.x, ++ui) {
        const int b = xmap ? (int)(blockIdx.x & 7) + 8 * ui : unit >> 5, r = xmap ? (int)(blockIdx.x >> 3) : unit & 31;
        const int r0 = min(max(r - 4, 0), 24);
        LAS bf16x8* qlds = (LAS bf16x8*)(lds + 69632 + h * 8192);
        {
            const bf16_t* qbase = Qb + (((size_t)(b * 32 + r) * 8 + h) * 8) * 512 + lane * 8;
#pragma unroll
            for (int qt = 0; qt < 4; ++qt)
#pragma unroll
                for (int ks = 0; ks < 2; ++ks) qlds[(qt * 2 + ks) * 64 + lane] = *(const bf16x8*)(qbase + (qt * 2 + ks) * 512);
        }
        f32x4 O[4][4]; float l[4];
#pragma unroll
        for (int qt = 0; qt < 4; ++qt) { l[qt] = 0.f;
#pragma unroll
            for (int nt = 0; nt < 4; ++nt) O[qt][nt] = (f32x4){0.f, 0.f, 0.f, 0.f}; }
        const bf16_t* kbase0 = Kb + (((size_t)(b * 32 + r0) * 8 + h) * 8) * 512 + lane * 8;
        const bf16_t* vbase0 = VT + (((size_t)(b * 32 + r0) * 8 + h) * 8) * 512 + lane * 8;
        bf16x8 kA[2][2], vA[4], kB[2][2], vB[4];
#define ATT_LOADH(KF, VF, jj, kb_) do { \
            _Pragma("unroll") for (int kt = 0; kt < 2; ++kt) _Pragma("unroll") for (int ks = 0; ks < 2; ++ks) KF[kt][ks] = *(const bf16x8*)(kbase0 + (size_t)(jj) * (8 * 8 * 512) + (((kb_) * 2 + kt) * 2 + ks) * 512); \
            _Pragma("unroll") for (int nt = 0; nt < 4; ++nt) VF[nt] = *(const bf16x8*)(vbase0 + (size_t)(jj) * (8 * 8 * 512) + ((kb_) * 4 + nt) * 512); } while (0)
#define ATT_HALF(KF, VF, kb_) do { \
            f32x4 s0_[3], s1_[3]; union { u32x4 u; bf16x8 v; } pf_[3]; \
            _Pragma("unroll") for (int q3 = 0; q3 < 3; ++q3) { const int qt = (kb_) + q3; \
                const bf16x8 qf0 = qlds[(qt * 2 + 0) * 64 + lane], qf1 = qlds[(qt * 2 + 1) * 64 + lane]; \
                { const LAS float* tb = trow + (32 * (kb_) + 8 * fq - (16 * qt + fr) + 15 + 48); s0_[q3] = (f32x4){tb[0], tb[1], tb[2], tb[3]}; s1_[q3] = (f32x4){tb[4], tb[5], tb[6], tb[7]}; } \
                s0_[q3] = __builtin_amdgcn_mfma_f32_16x16x32_bf16(KF[0][0], qf0, s0_[q3], 0, 0, 0); \
                s1_[q3] = __builtin_amdgcn_mfma_f32_16x16x32_bf16(KF[1][0], qf0, s1_[q3], 0, 0, 0); \
                s0_[q3] = __builtin_amdgcn_mfma_f32_16x16x32_bf16(KF[0][1], qf1, s0_[q3], 0, 0, 0); \
                s1_[q3] = __builtin_amdgcn_mfma_f32_16x16x32_bf16(KF[1][1], qf1, s1_[q3], 0, 0, 0); } \
            _Pragma("unroll") for (int q3 = 0; q3 < 3; ++q3) { const int qt = (kb_) + q3; \
                const int bi = qt == 0 ? 0 : (qt == 1 ? 1 + (kb_) : (qt == 2 ? 3 + (kb_) : 5)); \
                float p[8]; \
                _Pragma("unroll") for (int i = 0; i < 8; ++i) p[i] = __builtin_amdgcn_exp2f(i < 4 ? s0_[q3][i & 3] : s1_[q3][i & 3]); \
                const u32x4 mm = mskl[bi * 64 + lane]; \
                pf_[q3].u.x = cvt_pk_bf16(p[0], p[1]) & mm.x; pf_[q3].u.y = cvt_pk_bf16(p[2], p[3]) & mm.y; pf_[q3].u.z = cvt_pk_bf16(p[4], p[5]) & mm.z; pf_[q3].u.w = cvt_pk_bf16(p[6], p[7]) & mm.w; } \
            _Pragma("unroll") for (int q3 = 0; q3 < 3; ++q3) { const int qt = (kb_) + q3; \
                _Pragma("unroll") for (int nt = 0; nt < 4; ++nt) O[qt][nt] = __builtin_amdgcn_mfma_f32_16x16x32_bf16(VF[nt], pf_[q3].v, O[qt][nt], 0, 0, 0); \
                asm("v_dot2c_f32_bf16 %0, %1, %2" : "+v"(l[qt]) : "v"(0x3F803F80u), "v"(pf_[q3].u.x)); \
                asm("v_dot2c_f32_bf16 %0, %1, %2" : "+v"(l[qt]) : "v"(0x3F803F80u), "v"(pf_[q3].u.y)); \
                asm("v_dot2c_f32_bf16 %0, %1, %2" : "+v"(l[qt]) : "v"(0x3F803F80u), "v"(pf_[q3].u.z)); \
                asm("v_dot2c_f32_bf16 %0, %1, %2" : "+v"(l[qt]) : "v"(0x3F803F80u), "v"(pf_[q3].u.w)); } \
            } while (0)
        ATT_LOADH(kA, vA, 0, 0);
#pragma unroll 1
        for (int j = 0; j < 8; ++j) {
            const int dr = r0 + j - r + 7;
            const LAS float* trow = tbl + (h * 15 + dr) * 128;
            ATT_LOADH(kB, vB, j, 1);
            ATT_HALF(kA, vA, 0);
            { const int jn = j < 7 ? j + 1 : 7; ATT_LOADH(kA, vA, jn, 0); }
            ATT_HALF(kB, vB, 1);
        }
#undef ATT_LOADH
#undef ATT_HALF
        float ssq[4];
#pragma unroll
        for (int qt = 0; qt < 4; ++qt) {
            float lt = l[qt]; lt += __shfl_xor(lt, 16); lt += __shfl_xor(lt, 32);
            const float inv = __builtin_amdgcn_rcpf(lt); float ss = 0.f;
#pragma unroll
            for (int nt = 0; nt < 4; ++nt) { O[qt][nt] = O[qt][nt] * inv; ss += sq4(O[qt][nt]); }
            ss += __shfl_xor(ss, 16); ss += __shfl_xor(ss, 32);
            ssq[qt] = ss;
            if (fq == 0) red[h * 64 + 16 * qt + fr] = ss;
        }
        __syncthreads();
#pragma unroll
        for (int qt = 0; qt < 4; ++qt) {
            float tot = 0.f;
#pragma unroll
            for (int w = 0; w < 8; ++w) tot += red[w * 64 + 16 * qt + fr];
            const float rs = rsq(tot * (1.0f / AW) + EPS);
            bf16_t* op = MIX + (size_t)(b * SEQ + r * 64 + 16 * qt + fr) * DM + h * 64 + 4 * fq;
#pragma unroll
            for (int nt = 0; nt < 4; ++nt) { const f32x4 g4 = *(const f32x4*)(ga + h * 64 + 16 * nt + 4 * fq); const f32x4 a = O[qt][nt] * rs * g4;
                u32x2 w; w.x = cvt_pk_bf16(a[0], a[1]); w.y = cvt_pk_bf16(a[2], a[3]); *(u32x2*)(op + 16 * nt) = w; }
        }
        __syncthreads();
    }
}

#define XB_TMO      128
#define XB_XCNT(j)  (256  + 64 * (j))
#define XB_XSUB(j)  (1280 + 64 * (j))
#define XB_XGEN(j)  (2304 + 64 * (j))
#define XB_TOP      3328
#define XB_TOPGEN   3392
#define XCD_BAR_WORDS 3456
#define XB_SPIN_CAP (1u << 22)

__device__ __forceinline__ unsigned xb_ld(unsigned* p)              { return __hip_atomic_load(p, __ATOMIC_RELAXED, __HIP_MEMORY_SCOPE_AGENT); }
__device__ __forceinline__ unsigned xb_add(unsigned* p, unsigned v) { return __hip_atomic_fetch_add(p, v, __ATOMIC_RELAXED, __HIP_MEMORY_SCOPE_AGENT); }
__device__ __forceinline__ unsigned xb_xcc_id() { return (unsigned)__builtin_amdgcn_s_getreg((3 << 11) | 20) & 0xFu; }
#define XB_SPIN(cond, bar) do { unsigned _sp = 0; while (cond) { __builtin_amdgcn_s_sleep(1); \
    if ((++_sp & 255u) == 0u) { if (xb_ld(&(bar)[XB_TMO])) break; if (_sp > XB_SPIN_CAP) { atomicAdd(&(bar)[XB_TMO], 1u); break; } } } } while (0)

struct XcdBarrier {
    unsigned* bar; unsigned x;
    volatile LAS unsigned* st;
};

__device__ __forceinline__ XcdBarrier xcd_barrier_post(unsigned* bar, volatile LAS unsigned* st) {
    XcdBarrier b; b.bar = bar; b.x = xb_xcc_id(); b.st = st;
    if (threadIdx.x == 0) (void)xb_add(&bar[XB_XCNT(b.x)], 1u);
    return b;
}
__device__ __forceinline__ void xcd_barrier_complete(unsigned* bar, unsigned x, unsigned& nloc, unsigned& nx) {
    const unsigned G = gridDim.x * gridDim.y * gridDim.z;
    unsigned sum, cnt, mine, sp = 0u;
    for (;;) {
        sum = 0u; cnt = 0u; mine = 0u;
#pragma unroll
        for (unsigned j = 0; j < 16; ++j) { const unsigned c = xb_ld(&bar[XB_XCNT(j)]); sum += c; cnt += (c > 0u) ? 1u : 0u; mine = (j == x) ? c : mine; }
        if (sum == G) break;
        __builtin_amdgcn_s_sleep(1);
        if ((++sp & 255u) == 0u) { if (xb_ld(&bar[XB_TMO])) break; if (sp > XB_SPIN_CAP) { atomicAdd(&bar[XB_TMO], 1u); break; } }
    }
    nloc = mine > 0u ? mine : 1u; nx = cnt > 0u ? cnt : 1u;
}

__device__ __forceinline__ void xcd_barrier(const XcdBarrier& b) {
    asm volatile("s_waitcnt vmcnt(0)" ::: "memory");
    __syncthreads();
    if (threadIdx.x == 0) {
        unsigned* bar = b.bar;
        __builtin_amdgcn_s_waitcnt(0);
        unsigned nloc = b.st[0], nx = b.st[1];
        if (nloc == 0u) { xcd_barrier_complete(bar, b.x, nloc, nx); b.st[0] = nloc; b.st[1] = nx; }
        const unsigned old = xb_add(&bar[XB_XSUB(b.x)], 1u);
        const unsigned gen = old / nloc;
        if (old + 1u == (gen + 1u) * nloc) {
            __builtin_amdgcn_fence(__ATOMIC_RELEASE, "agent");
            asm volatile("s_waitcnt vmcnt(0)" ::: "memory");
            const unsigned og = xb_add(&bar[XB_TOP], 1u);
            const unsigned tg = og / nx;
            if (og + 1u == (tg + 1u) * nx) xb_add(&bar[XB_TOPGEN], 1u);
            else XB_SPIN(xb_ld(&bar[XB_TOPGEN]) == tg, bar);
            __builtin_amdgcn_fence(__ATOMIC_ACQUIRE, "agent");
            xb_add(&bar[XB_XGEN(b.x)], 1u);
            asm volatile("s_waitcnt vmcnt(0)" ::: "memory");
        } else {
            XB_SPIN(xb_ld(&bar[XB_XGEN(b.x)]) == gen, bar);
            __builtin_amdgcn_fence(__ATOMIC_ACQUIRE, "agent");
            asm volatile("s_waitcnt vmcnt(0)" ::: "memory");
        }
    }
    __syncthreads();
}


__global__ void __launch_bounds__(512, 2) fwd_kernel(Args args) {
    extern __shared__ __attribute__((aligned(16))) unsigned char lds_raw[];
    LAS unsigned char* lds = (LAS unsigned char*)lds_raw;
    const int G = gridDim.x, bid = blockIdx.x;
    typedef const __attribute__((address_space(4))) unsigned char* kptr_t;
    const kptr_t kbase = (kptr_t)__builtin_amdgcn_kernarg_segment_ptr();
#define INP(idx) ({ kptr_t _k = kbase; asm volatile("" : "+s"(_k)); *(const float* const __attribute__((address_space(4)))*)(_k + 8 * (idx)); })
#define WSP(T, off) ({ kptr_t _k = kbase; asm volatile("" : "+s"(_k)); (T*)(*(unsigned char* const __attribute__((address_space(4)))*)(_k + 200) + (off)); })
#define x_in INP(0)
#define c_in INP(1)
#define norm1_g INP(2)
#define norm2_g INP(3)
#define w_ada INP(4)
#define b_ada INP(5)
#define w_in INP(6)
#define q_norm_g INP(7)
#define k_norm_g INP(8)
#define rel_bias INP(9)
#define lam_re INP(10)
#define lam_im INP(11)
#define log_dt INP(12)
#define b_re INP(13)
#define b_im INP(14)
#define c_re INP(15)
#define c_im INP(16)
#define ssm_d INP(17)
#define w_glu INP(18)
#define attn_out_g INP(19)
#define ssm_out_g INP(20)
#define w_out INP(21)
#define w_mlp1 INP(22)
#define w_mlp2 INP(23)
#define OUTP ({ kptr_t _k = kbase; asm volatile("" : "+s"(_k)); *(float* const __attribute__((address_space(4)))*)(_k + 192); })
#define MOD WSP(float, WS_MOD)
#define GM1 WSP(float, WS_GM1)
#define GM2 WSP(float, WS_GM2)
#define TBLG WSP(float, WS_TBLG)
#define SHW1 WSP(float, WS_SHW1)
#define SHW2 WSP(float, WS_SHW2)
#define PW WSP(f32x2, WS_PW)
#define BBAR WSP(f32x2, WS_BBAR)
#define KT WSP(float, WS_KT)
#define STATX WSP(float, WS_STATX)
#define STATS WSP(float, WS_STATS)
#define WQKU WSP(bf16_t, WS_WQKU)
#define WV WSP(bf16_t, WS_WV)
#define WGLU WSP(bf16_t, WS_WGLU)
#define WOUT WSP(bf16_t, WS_WOUT)
#define W1 WSP(bf16_t, WS_W1)
#define W2 WSP(bf16_t, WS_W2)
#define BT3 WSP(bf16_t, WS_BT3)
#define QS1 WSP(bf16_t, WS_QS1)
#define AX WSP(bf16_t, WS_AX)
#define QB WSP(bf16_t, WS_QB)
#define KB WSP(bf16_t, WS_KB)
#define VT WSP(bf16_t, WS_VT)
#define A3 WSP(bf16_t, WS_A3)
#define LB WSP(float, WS_LB)
#define Z WSP(bf16_t, WS_Z)
#define MIX WSP(bf16_t, WS_MIX)
#define HB WSP(bf16_t, WS_H)
    const int lo = args.ph_lo, hi = args.ph_hi;
    volatile LAS unsigned* xb_st = (volatile LAS unsigned*)(lds + LDS_BYTES - 16);
    if (threadIdx.x == 0) { xb_st[0] = 0u; xb_st[1] = 0u; }
    __syncthreads();
    XcdBarrier xbar = xcd_barrier_post(WSP(unsigned, 0), xb_st);
    for (int ph = lo; ph < hi; ++ph) {
      const int cls_ = ph < 3 ? ph : 3 + ((ph - 3) & 7);
      const int nrep_ = ((((DUPM) >> cls_) & 1u) && !(cls_ == 8 && ph >= 11) && cls_ != 10) ? 2 : 1;
      for (int rep_ = 0; rep_ < nrep_; ++rep_) {
        if ((ph > lo || rep_) && cls_ != 5) { if (hi < 0) cg::this_grid().sync(); else xcd_barrier(xbar); }
        int tid = threadIdx.x; asm volatile("" : "+v"(tid));
        const int lane = tid & 63, wave = __builtin_amdgcn_readfirstlane(tid >> 6);
        const int gw = bid * 8 + wave, NGW = G * 8;
        const int gt = bid * 512 + tid, NGT = G * 512;
        if (ph == 0) { if (PHON(0)) {
            if (bid < 192) {
                LAS bf16_t* S16 = (LAS bf16_t*)lds;
                { const float* cp = c_in; for (int i = tid; i < NB * DM; i += 512) { const float v = cp[i]; S16[(i >> 10) * S16_LD + (i & 1023)] = (bf16_t)f2bf(v * __builtin_amdgcn_rcpf(1.0f + __builtin_amdgcn_exp2f(-LOG2E * v))); } }
                __syncthreads();
                const int l = bid / 96, chunk = bid % 96;
                gemv32_task(lds, w_ada + (size_t)l * DM * (NMOD * DM), NMOD * DM, chunk * 64, b_ada + (size_t)l * NMOD * DM, MOD + (size_t)l * NB * NMOD * DM, NMOD * DM, tid);
            }
            {
                LAS float* scr = (LAS float*)(lds + wave * 16384);
                constexpr int I_QKU = 48 * 16, I_V = 16 * 16, I_GLU = 16 * 8, I_OUT = 32 * 16, I_1 = 128 * 16, I_2 = 32 * 64, I_L = I_QKU + I_V + I_GLU + I_OUT + I_1 + I_2;
                constexpr int NA = 2560;
                const bool front = (G == 256);
                for (int pass = 0; pass < 2; ++pass)
                for (int it = front ? (pass == 0 ? (bid >= 192 ? (bid - 192) * 8 + wave : 2 * I_L) : NA + gw) : (pass == 0 ? gw : 2 * I_L); it < (front && pass == 0 ? NA : 2 * I_L); it += (front && pass == 0 ? 512 : NGW)) {
                    const int l = it / I_L; int r = it % I_L;
                    if (r < I_QKU) { const int nb = r / 16, kb = r % 16, pn = nb >> 3, lb = nb & 7;
                        const int src = (pn < 4 ? 256 * pn : 1536 + 256 * (pn - 4)) + 64 * (lb & 3) + 32 * (lb >> 2);
                        transpose_item(w_in + (size_t)l * DM * INC, INC, 64 * kb, src, WQKU + (size_t)l * 1536 * DM, DM, 32 * nb, 64 * kb, scr, lane); continue; } r -= I_QKU;
                    if (r < I_V) { const int nb = r / 16, kb = r % 16;
                        transpose_item(w_in + (size_t)l * DM * INC, INC, 64 * kb, 1024 + 32 * nb, WV + (size_t)l * 512 * DM, DM, 32 * nb, 64 * kb, scr, lane); continue; } r -= I_V;
                    if (r < I_GLU) { const int nb = r / 8, kb = r % 8;
                        transpose_item(w_glu + (size_t)l * SW * SW, SW, 64 * kb, 32 * nb, WGLU + (size_t)l * SW * SW, SW, 32 * nb, 64 * kb, scr, lane); continue; } r -= I_GLU;
                    if (r < I_OUT) { const int nb = r / 16, kb = r % 16;
                        transpose_item(w_out + (size_t)l * DM * DM, DM, 64 * kb, 32 * nb, WOUT + (size_t)l * DM * DM, DM, 32 * nb, 64 * kb, scr, lane); continue; } r -= I_OUT;
                    if (r < I_1) { const int nb = r / 16, kb = r % 16;
                        transpose_item(w_mlp1 + (size_t)l * DM * DFF, DFF, 64 * kb, 32 * nb, W1 + (size_t)l * DFF * DM, DM, 32 * nb, 64 * kb, scr, lane); continue; } r -= I_1;
                    { const int nb = r / 64, kb = r % 64;
                        transpose_item(w_mlp2 + (size_t)l * DFF * DM, DM, 64 * kb, 32 * nb, W2 + (size_t)l * DM * DFF, DFF, 32 * nb, 64 * kb, scr, lane); }
                }
            }
            for (int idx = gt; idx < DEPTH * 2 * NG * SP; idx += NGT) {
                const int p = idx & 63, ldg = idx >> 6, gi = ldg & 31;
                const double lre = fmin((double)lam_re[idx], -1e-4), lim = (double)lam_im[idx];
                const double dt = (double)expf(log_dt[ldg]);
                double sn, cs; dsincos_red(lim * dt, sn, cs); const double mg = dexp_small(lre * dt);
                const double lbr = mg * cs, lbi = mg * sn;
                double pr = 1.0, pi = 0.0;
                f32x2* pw = PW + (size_t)ldg * 33 * 64 + p;
#pragma unroll 1
                for (int d = 0; d <= 32; ++d) { pw[d * 64] = (f32x2){(float)pr, (float)pi}; const double nr = pr * lbr - pi * lbi, ni = pr * lbi + pi * lbr; pr = nr; pi = ni; }
                const double den = lre * lre + lim * lim, cr = ((lbr - 1.0) * lre + lbi * lim) / den, ci = (lbi * lre - (lbr - 1.0) * lim) / den;
                (void)gi;
#pragma unroll 1
                for (int h = 0; h < SG; ++h) { const double br = (double)b_re[(size_t)idx * SG + h], bi = (double)b_im[(size_t)idx * SG + h];
                    BBAR[(size_t)idx * SG + h] = (f32x2){(float)(cr * br - ci * bi), (float)(cr * bi + ci * br)}; }
            }
        } } else if (ph == 1) { if (PHON(1)) {
            for (int i = gt; i < DEPTH * NB * DM; i += NGT) { const int k = i & 1023, lb = i >> 10, l = lb >> 5;
                GM1[i] = norm1_g[l * DM + k] * (1.0f + MOD[(size_t)lb * (NMOD * DM) + 1 * DM + k]);
                GM2[i] = norm2_g[l * DM + k] * (1.0f + MOD[(size_t)lb * (NMOD * DM) + 4 * DM + k]); }
            for (int l2 = 0; l2 < DEPTH; ++l2) {
                LAS float* redl = (LAS float*)(lds + 32768);
                float mq = fabsf(q_norm_g[l2 * HD + lane]), mk = fabsf(k_norm_g[l2 * HD + lane]), mb = 0.f;
                const float* relb = rel_bias + (size_t)l2 * NH * 15 * 31;
                for (int i = tid; i < NH * 15 * 31; i += 512) mb = fmaxf(mb, fabsf(relb[i]));
#pragma unroll
                for (int o = 1; o < 64; o <<= 1) { mq = fmaxf(mq, __shfl_xor(mq, o)); mk = fmaxf(mk, __shfl_xor(mk, o)); mb = fmaxf(mb, __shfl_xor(mb, o)); }
                if (lane == 0) redl[wave] = mb;
                __syncthreads();
#pragma unroll
                for (int w = 0; w < 8; ++w) mb = fmaxf(mb, redl[w]);
                const float cshift = 8.0f * mq * mk + mb;
                float* tg = TBLG + (size_t)l2 * NH * 15 * 128;
                for (int i = gt; i < NH * 15 * 128; i += NGT) { const int x = (i & 127) - 48, hd = i >> 7; tg[i] = (x >= 0 && x <= 30) ? (relb[hd * 31 + x] - cshift) * LOG2E : 0.f; }
                __syncthreads();
            }
            for (int t = bid; t < 256; t += G) {
                const int l = t >> 7, gi = (t >> 2) & 31, dir = (t >> 1) & 1, dh = t & 1, ldg = (l * 2 + dir) * 32 + gi;
                LAS f32x2* pwl = (LAS f32x2*)lds; LAS f32x2* bbl = (LAS f32x2*)(lds + 8192); LAS float* crl = (LAS float*)(lds + 16384); LAS float* cil = (LAS float*)(lds + 20480);
                { const f32x2* pwg = PW + ((size_t)ldg * 33 + 16 * dh) * 64; const f32x2* bbg = BBAR + (size_t)ldg * 1024; const float* crg = c_re + (size_t)ldg * 1024; const float* cig = c_im + (size_t)ldg * 1024;
                  for (int i = tid; i < 1024; i += 512) { pwl[i] = pwg[i]; bbl[i] = bbg[i]; crl[i] = crg[i]; cil[i] = cig[i]; } }
                __syncthreads();
                const int ci = tid & 15, ch = (tid >> 4) & 15, dsub = tid >> 8;
                float a8[8];
#pragma unroll
                for (int e = 0; e < 8; ++e) a8[e] = 0.f;
                for (int p = 0; p < 64; ++p) {
                    const f32x2 bv = bbl[p * 16 + ci]; const float c_r = crl[ch * 64 + p], c_i = cil[ch * 64 + p];
                    const float cbr = c_r * bv.x - c_i * bv.y, cbi = c_r * bv.y + c_i * bv.x;
#pragma unroll
                    for (int e = 0; e < 8; ++e) { const f32x2 w = pwl[(dsub * 8 + e) * 64 + p]; a8[e] += cbr * w.x - cbi * w.y; }
                }
                float* ktp = KT + ((size_t)((l * NG + gi) * 2 + dir) * 32 + 16 * dh + dsub * 8) * 256 + ch * 16 + ci;
#pragma unroll
                for (int e = 0; e < 8; ++e) ktp[e * 256] = a8[e];
                __syncthreads();
            }
            for (int i = gt; i < DEPTH * NG * 256 * 64; i += NGT) {
                const int k8 = i & 63, n = (i >> 6) & 255, gi = (i >> 14) & 31, l = i >> 19;
                const int dir = n >> 7, ri = (n >> 6) & 1, p = n & 63, s = k8 >> 1, ci0 = (k8 & 1) * 8;
                const int ldg = (l * 2 + dir) * 32 + gi, dl = dir == 0 ? 31 - s : s;
                const f32x2 w = PW[((size_t)ldg * 33 + dl) * 64 + p]; const f32x2* bb = BBAR + ((size_t)ldg * 64 + p) * 16 + ci0;
                float v[8];
#pragma unroll
                for (int e = 0; e < 8; ++e) { const f32x2 bv = bb[e]; v[e] = ri ? (w.x * bv.y + w.y * bv.x) : (w.x * bv.x - w.y * bv.y); }
                u32x4 o; o.x = pk2(v[0], v[1]); o.y = pk2(v[2], v[3]); o.z = pk2(v[4], v[5]); o.w = pk2(v[6], v[7]);
                *(u32x4*)(QS1 + ((size_t)(l * NG + gi) * 256 + n) * 512 + k8 * 8) = o;
            }
            for (int i = gt; i < DEPTH * NG * 512 * 32; i += NGT) {
                const int kk8 = i & 31, n = (i >> 5) & 511, gi = (i >> 14) & 31, l = i >> 19;
                const int kk = kk8 * 8, dir = kk >> 7, ri = (kk >> 6) & 1, p0 = kk & 63, tau = n >> 4, ch = n & 15;
                const int ldg = (l * 2 + dir) * 32 + gi, e0 = dir == 0 ? tau + 1 : 32 - tau;
                const f32x2* pw = PW + ((size_t)ldg * 33 + e0) * 64 + p0; const float* cr = c_re + ((size_t)ldg * 16 + ch) * 64 + p0; const float* cim = c_im + ((size_t)ldg * 16 + ch) * 64 + p0;
                float v[8];
#pragma unroll
                for (int e = 0; e < 8; ++e) { const f32x2 w = pw[e]; v[e] = ri ? -(cr[e] * w.y + cim[e] * w.x) : (cr[e] * w.x - cim[e] * w.y); }
                u32x4 o; o.x = pk2(v[0], v[1]); o.y = pk2(v[2], v[3]); o.z = pk2(v[4], v[5]); o.w = pk2(v[6], v[7]);
                *(u32x4*)(BT3 + ((size_t)(l * NG + gi) * 512 + n) * 768 + 512 + kk) = o;
            }
        } } else if (ph == 2) { if (PHON(2)) {
            if (bid < 192) {
                const int l = bid / 96, t = bid % 96;
                LAS bf16_t* S16 = (LAS bf16_t*)lds;
                const float* src = MOD + (size_t)l * NB * NMOD * DM + (t < 32 ? 0 : 3 * DM);
                for (int i = tid; i < NB * DM; i += 512) S16[(i >> 10) * S16_LD + (i & 1023)] = (bf16_t)f2bf(src[(size_t)(i >> 10) * (NMOD * DM) + (i & 1023)]);
                __syncthreads();
                if (t < 32) gemv32_task(lds, w_in + (size_t)l * DM * INC, INC, t * 64, nullptr, SHW1 + (size_t)l * NB * INC, INC, tid);
                else gemv32_task(lds, w_mlp1 + (size_t)l * DM * DFF, DFF, (t - 32) * 64, nullptr, SHW2 + (size_t)l * NB * DFF, DFF, tid);
            }
            {
                const float* ktp = KT; const float* dsp = ssm_d; bf16_t* bt3p = BT3;
                for (int i = gt; i < DEPTH * NG * 512 * 64; i += NGT) {
                    const int k8 = i & 63, n = (i >> 6) & 511, gi = (i >> 15) & 31, l = i >> 20;
                    const int s_ = k8 >> 1, ci0 = (k8 & 1) * 8, tau = n >> 4, ch = n & 15;
                    const float* ktg = ktp + ((size_t)(l * NG + gi) * 2) * 32 * 256;
                    const int dir = s_ > tau ? 1 : 0, dl = s_ > tau ? s_ - tau : tau - s_;
                    const f32x4* kp = (const f32x4*)(ktg + ((size_t)(dir * 32 + dl) * 16 + ch) * 16 + ci0);
                    f32x4 va = kp[0], vb = kp[1];
                    if (s_ == tau) { const f32x4* kq = (const f32x4*)(ktg + ((size_t)(32) * 16 + ch) * 16 + ci0); va = va + kq[0]; vb = vb + kq[1];
                        const float dsk = dsp[(size_t)(l * NG + gi) * SG + ch]; const int e = ch - ci0;
                        if (e >= 0 && e < 4) va[e] += dsk; else if (e >= 4 && e < 8) vb[e - 4] += dsk; }
                    u32x4 o; o.x = pk2(va[0], va[1]); o.y = pk2(va[2], va[3]); o.z = pk2(vb[0], vb[1]); o.w = pk2(vb[2], vb[3]);
                    *(u32x4*)(bt3p + ((size_t)(l * NG + gi) * 512 + n) * 768 + k8 * 8) = o;
                }
            }
            {
                const float* xp = x_in; const float* gmp = GM1; bf16_t* axp = AX; float* stp = STATX;
                constexpr int RA = 16384;
                const bool front = (G == 256);
                for (int pass = 0; pass < 2; ++pass)
                for (int rp = front ? (pass == 0 ? (bid >= 192 ? (bid - 192) * 8 + wave : NTOK) : RA / 2 + gw) : (pass == 0 ? gw : NTOK); rp < (front && pass == 0 ? RA / 2 : NTOK / 2); rp += (front && pass == 0 ? 512 : NGW)) {
                    const int row = 2 * rp, b = row >> 11;
                    const f32x4* xr = (const f32x4*)(xp + (size_t)row * DM) + lane; const f32x4* gmr = (const f32x4*)(gmp + (size_t)b * DM) + lane;
                    f32x4 v[8];
#pragma unroll
                    for (int j = 0; j < 8; ++j) v[j] = xr[64 * j];
                    u32x2* o8 = (u32x2*)(axp + (size_t)row * DM) + lane; float s0 = 0.f, s1 = 0.f;
#pragma unroll
                    for (int j = 0; j < 8; ++j) { if (j < 4) s0 += sq4(v[j]); else s1 += sq4(v[j]); const f32x4 a = v[j] * gmr[64 * (j & 3)]; u32x2 w; w.x = cvt_pk_bf16(a[0], a[1]); w.y = cvt_pk_bf16(a[2], a[3]); o8[64 * j] = w; }
                    s0 = wave_sum(s0); s1 = wave_sum(s1);
                    if (lane < 32) stp[(size_t)row * 16 + lane] = lane == 0 ? s0 : (lane == 16 ? s1 : 0.f);
                }
            }
        } } else {
            const int l = (ph - 3) >> 3, sub = (ph - 3) & 7;
            const float* modl = MOD + (size_t)l * NB * NMOD * DM;
            if (sub == 0) { if (PHON(3)) {
                { pg8::Gemm g{AX, WQKU + (size_t)l * 1536 * DM, DM, DM, DM}; pg8::StaticOrder S; S.init(NTOK, 1536, G, bid); S.rev = (l > 0);
                  EpiIn E{STATX, SHW1 + (size_t)l * NB * INC, q_norm_g + l * HD, k_norm_g + l * HD, QB, A3, (LAS float*)(lds + 131072)};
                  pg8::gemm_phase<EpiIn, pg8::StaticOrder, true>(lds, g, S, E); }
                { pg8::Gemm g{WV + (size_t)l * 512 * DM, AX, DM, DM, DM}; pg8::StaticOrder S; S.init(512, NTOK, G, bid);
                  EpiVt E{STATX, SHW1 + (size_t)l * NB * INC, VT, (LAS float*)(lds + 131072)};
                  pg8::gemm_phase<EpiVt, pg8::StaticOrder, true>(lds, g, S, E); }
            } } else if (sub == 1) { if (PHON(4)) {
#ifndef NO_S1
                if (G == 256) {
                    if (!(DUP_ONLY_ATTN && rep_)) {
                    pg8::Gemm g{A3, QS1 + (size_t)l * NG * 256 * 512, 768, 512, 512}; pg8::GroupOrder<1> S; S.init(G, bid);
                    EpiS1F E{PW + (size_t)l * 2 * 32 * 33 * 64, A3};
                    pg8::gemm_phase<EpiS1F, pg8::GroupOrder<1>, true>(lds, g, S, E); }
                } else {
                if (!(DUP_ONLY_ATTN && rep_))
                { pg8::Gemm g{A3, QS1 + (size_t)l * NG * 256 * 512, 768, 512, 512}; pg8::GroupOrder<1> S; S.init(G, bid);
                  EpiS1 E{LB};
                  pg8::gemm_phase<EpiS1, pg8::GroupOrder<1>, true>(lds, g, S, E); }
                for (int L_ = bid; L_ < 256; L_ += G) {
                    const int p = tid & 63, dir = (tid >> 6) & 1, gi = L_ >> 3, b = 4 * (L_ & 7) + (tid >> 7);
                    const f32x2 w = PW[((size_t)((l * 2 + dir) * 32 + gi) * 33 + 32) * 64 + p];
                    float hr = 0.f, hi_ = 0.f;
                    const size_t rbase = (size_t)gi * 2048 + b * NCH;
                    const float* LBp = LB; bf16_t* A3p = A3;
                    for (int c8 = 0; c8 < NCH; c8 += 8) {
                        float lr[8], li[8];
#pragma unroll
                        for (int e = 0; e < 8; ++e) { const int ch = dir == 0 ? c8 + e : NCH - 1 - (c8 + e); const float* lp = LBp + (rbase + ch) * 256 + dir * 128 + p; lr[e] = lp[0]; li[e] = lp[64]; }
#pragma unroll
                        for (int e = 0; e < 8; ++e) { const int ch = dir == 0 ? c8 + e : NCH - 1 - (c8 + e);
                            bf16_t* ap = A3p + (rbase + ch) * 768 + 512 + dir * 128 + p;
                            ap[0] = (bf16_t)f2bf(hr); ap[64] = (bf16_t)f2bf(hi_);
                            const float nr = w.x * hr - w.y * hi_ + lr[e], ni = w.x * hi_ + w.y * hr + li[e];
                            hr = nr; hi_ = ni; }
                    }
                }
                }
#endif
#ifndef NO_ATTN
                attn_phase(lds, QB, KB, VT, MIX, TBLG + (size_t)l * NH * 15 * 128, attn_out_g + l * AW);
#endif
            } } else if (sub == 2) { if (PHON(5)) {
                (void)0;
            } } else if (sub == 3) { if (PHON(6)) {
                pg8::Gemm g{A3, BT3 + (size_t)l * NG * 512 * 768, 768, 768, 768}; pg8::GroupOrder<2> S; S.init(G, bid);
                EpiS3 E{Z};
                pg8::gemm_phase<EpiS3, pg8::GroupOrder<2>, true>(lds, g, S, E);
            } } else if (sub == 4) { if (PHON(7)) {
                pg8::Gemm g{Z, WGLU + (size_t)l * SW * SW, SW, SW, SW}; pg8::PairOrder S; S.init(G, bid);
                EpiGlu E{Z, ssm_out_g + l * SW, STATS, MIX};
                pg8::gemm_phase<EpiGlu, pg8::PairOrder, true>(lds, g, S, E);
                __builtin_amdgcn_fence(__ATOMIC_RELEASE, "workgroup"); __syncthreads(); __builtin_amdgcn_fence(__ATOMIC_ACQUIRE, "workgroup");
                for (int pm = bid; pm < 256; pm += G)
                    for (int r0_ = wave; r0_ < 256; r0_ += 64) {
                        u32x4 wv[8]; float rsv[8];
                        const float* stp = STATS; bf16_t* mixp = MIX;
#pragma unroll
                        for (int e = 0; e < 8; ++e) { const int row = pm * 256 + r0_ + 8 * e;
                            const f32x4* sp = (const f32x4*)(stp + (size_t)row * 8);
                            rsv[e] = rsq((sum4(sp[0]) + sum4(sp[1])) * (1.0f / SW) + EPS);
                            wv[e] = *((const u32x4*)(mixp + (size_t)row * DM + AW) + lane); }
                        asm volatile("" ::: "memory");
#pragma unroll
                        for (int e = 0; e < 8; ++e) { const int row = pm * 256 + r0_ + 8 * e; const float rs = rsv[e]; u32x4 w = wv[e];
                            w.x = cvt_pk_bf16(bf_lo(w.x) * rs, bf_hi(w.x) * rs); w.y = cvt_pk_bf16(bf_lo(w.y) * rs, bf_hi(w.y) * rs);
                            w.z = cvt_pk_bf16(bf_lo(w.z) * rs, bf_hi(w.z) * rs); w.w = cvt_pk_bf16(bf_lo(w.w) * rs, bf_hi(w.w) * rs);
                            *((u32x4*)(mixp + (size_t)row * DM + AW) + lane) = w; }
                    }
            } } else if (sub == 5) { if (PHON(8)) {
                pg8::Gemm g{MIX, WOUT + (size_t)l * DM * DM, DM, DM, DM}; pg8::StaticOrder S; S.init(NTOK, DM, G, bid);
                EpiRes E{l == 0 ? x_in : (const float*)OUTP, OUTP, modl + 2 * DM, NMOD * DM, GM2 + (size_t)l * NB * DM, AX, STATX, (LAS float*)(lds + 131072 + 1024), 0};
                pg8::gemm_phase<EpiRes, pg8::StaticOrder, true>(lds, g, S, E);
            } } else if (sub == 6) { if (PHON(9)) {
                pg8::Gemm g{AX, W1 + (size_t)l * DFF * DM, DM, DM, DM}; pg8::StaticOrder S; S.init(NTOK, DFF, G, bid); S.rev = 1;
                EpiMlp1 E{STATX, SHW2 + (size_t)l * NB * DFF, HB, (LAS float*)(lds + 131072)};
                pg8::gemm_phase<EpiMlp1, pg8::StaticOrder, true>(lds, g, S, E);
            } } else { if (PHON(10)) {
                pg8::Gemm g{HB, W2 + (size_t)l * DM * DFF, DFF, DFF, DFF}; pg8::StaticOrder S; S.init(NTOK, DM, G, bid);
                EpiRes E{OUTP, OUTP, modl + 5 * DM, NMOD * DM, (l + 1 < DEPTH) ? GM1 + (size_t)(l + 1) * NB * DM : nullptr, AX, STATX, (LAS float*)(lds + 131072 + 1024), 1};
                pg8::gemm_phase<EpiRes, pg8::StaticOrder, true>(lds, g, S, E);
            } }
        }
      }
    }
}

extern "C" void kernel_launch(void* const* d_in, const int* in_sizes, int n_in, void* d_out, int out_size, void* d_ws, size_t ws_size, hipStream_t stream) {
    static int grid = 0;
    if (grid == 0) {
        if (n_in != 24 || ws_size < WS_END) { fprintf(stderr, "kernel_launch: unexpected n_in %d / ws %zu\n", n_in, ws_size); grid = -1; return; }
        int dev = 0, cus = 0;
        hipGetDevice(&dev); hipDeviceGetAttribute(&cus, hipDeviceAttributeMultiprocessorCount, dev);
        if (hipFuncSetAttribute((const void*)fwd_kernel, hipFuncAttributeMaxDynamicSharedMemorySize, LDS_BYTES) != hipSuccess) { fprintf(stderr, "kernel_launch: hipFuncSetAttribute failed\n"); grid = -1; return; }
        int per_cu = 0;
        if (hipOccupancyMaxActiveBlocksPerMultiprocessor(&per_cu, (const void*)fwd_kernel, 512, LDS_BYTES) != hipSuccess || per_cu < 1) { fprintf(stderr, "kernel_launch: occupancy query says %d\n", per_cu); per_cu = 1; }
        (void)hipGetLastError();
        grid = cus > 0 ? cus : 256;
    }
    if (grid < 0) return;
    Args a{};
    for (int i = 0; i < 24; ++i) a.in[i] = (const float*)d_in[i];
    a.out = (float*)d_out; a.ws = (unsigned char*)d_ws;
#if N_LAUNCH_PER_PHASE
    for (int ph = 0; ph < NPH; ++ph) { a.ph_lo = ph; a.ph_hi = ph + 1; hipLaunchKernelGGL(fwd_kernel, dim3(grid), dim3(512), LDS_BYTES, stream, a); }
#else
    a.ph_lo = 0; a.ph_hi = NPH;
    if (hipMemsetAsync(d_ws, 0, 16384, stream) != hipSuccess) { fprintf(stderr, "kernel_launch: memset of the barrier words failed\n"); return; }
    void* kargs[] = {&a};
    hipError_t e = hipLaunchCooperativeKernel((const void*)fwd_kernel, dim3(grid), dim3(512), kargs, LDS_BYTES, stream);
    if (e != hipSuccess) fprintf(stderr, "cooperative launch failed: %s (grid %d)\n", hipGetErrorString(e), grid);
#endif
}
```

```cpp
#include <hip/hip_runtime.h>
#include <hip/hip_cooperative_groups.h>
#include <cstdio>
#include <cstdint>
namespace cg = cooperative_groups;

#ifndef N_LAUNCH_PER_PHASE
#define N_LAUNCH_PER_PHASE 0
#endif
#ifndef PHM
#define PHM 0xFFFFu
#endif
#define PHON(k) (((PHM) >> (k)) & 1u)
#ifndef DUP_ONLY_ATTN
#define DUP_ONLY_ATTN 0
#endif
#ifndef DUPM
#define DUPM 0u
#endif

#define LAS __attribute__((address_space(3)))
typedef unsigned short bf16_t;
typedef short bf16x8 __attribute__((ext_vector_type(8)));
typedef float f32x4 __attribute__((ext_vector_type(4)));
typedef float f32x2 __attribute__((ext_vector_type(2)));
typedef unsigned u32x4 __attribute__((ext_vector_type(4)));
typedef unsigned u32x2 __attribute__((ext_vector_type(2)));

constexpr int DM = 1024, NB = 32, SEQ = 2048, NTOK = NB * SEQ, DEPTH = 2;
constexpr int AW = 512, SW = 512, NH = 8, HD = 64, NG = 32, SG = 16, SP = 64, DFF = 4096, INC = 2048, NMOD = 6;
constexpr int CT = 32, NCH = SEQ / CT;
constexpr float EPS = 1e-6f;
constexpr float LOG2E = 1.4426950408889634f;

constexpr size_t MiB = 1u << 20;
constexpr size_t WS_MOD = 1 * MiB;
constexpr size_t WS_GM1 = 3 * MiB;
constexpr size_t WS_GM2 = WS_GM1 + 256 * 1024;
constexpr size_t WS_TBLG = WS_GM1 + 512 * 1024;
constexpr size_t WS_SHW1 = 4 * MiB;
constexpr size_t WS_SHW2 = 5 * MiB;
constexpr size_t WS_PW = 6 * MiB;
constexpr size_t WS_BBAR = 9 * MiB;
constexpr size_t WS_KT = 10 * MiB;
constexpr size_t WS_STATX = 14 * MiB;
constexpr size_t WS_STATS = 18 * MiB;
constexpr size_t WS_WQKU = 20 * MiB;
constexpr size_t WS_WV = 26 * MiB;
constexpr size_t WS_WGLU = 28 * MiB;
constexpr size_t WS_WOUT = 29 * MiB;
constexpr size_t WS_W1 = 33 * MiB;
constexpr size_t WS_W2 = 49 * MiB;
constexpr size_t WS_BT3 = 65 * MiB;
constexpr size_t WS_QS1 = 113 * MiB;
constexpr size_t WS_AX = 129 * MiB;
constexpr size_t WS_OV = 257 * MiB;
constexpr size_t WS_QB = WS_OV;
constexpr size_t WS_KB = WS_OV + 64 * MiB;
constexpr size_t WS_VT = WS_OV + 128 * MiB;
constexpr size_t WS_A3 = WS_OV + 192 * MiB;
constexpr size_t WS_LB = WS_OV + 288 * MiB;
constexpr size_t WS_Z = WS_OV + 352 * MiB;
constexpr size_t WS_MIX = WS_OV + 416 * MiB;
constexpr size_t WS_H = WS_OV;
constexpr size_t WS_END = WS_OV + 544 * MiB;
static_assert(WS_KB - WS_QB == (size_t)NTOK * AW * 2, "Kb = Qb + NTOK*AW");

namespace pg8 {
constexpr int BM = 256, BK = 64, HALF = 128, HTB = HALF * BK * 2, STAGE_BYTES = 8 * HTB, NXCD = 8, WGM = 8;
__host__ __device__ __forceinline__ int lds_byte(int r, int c) { const int st = (r >> 4) * 2 + (c >> 5), rr = r & 15, cc = c & 31, ob = rr * 64 + cc * 2; return st * 1024 + (ob ^ (((ob >> 9) & 1) << 5)); }
__host__ __device__ __forceinline__ void stage_rc(int b, int& R, int& C) { const int st = b / 1024, sb = b % 1024, swz = sb ^ (((sb >> 9) & 1) << 5); R = (st >> 1) * 16 + swz / 64; C = (st & 1) * 32 + (swz % 64) / 2; }
__host__ __device__ __forceinline__ int perm32(int rho) { const int n = rho >> 4, i = rho & 15; return 8 * (i >> 2) + 4 * n + (i & 3); }

struct Unit { int pm, pn; };
struct Gemm { const bf16_t* A; const bf16_t* Bt; int lda, ldb, K; };

struct StaticOrder {
    int nM, nN, nwg, G, c; int rev = 0;
    __device__ __forceinline__ void init(int M, int N, int G_, int c_) { nM = M / BM; nN = N / BM; nwg = nM * nN; G = G_; c = c_; }
    __device__ __forceinline__ bool next(int i, Unit& u) const {
        const long L = (long)i * G + c; if (L >= nwg) return false;
        int wgid = (int)L; { const int q = nwg / NXCD, r = nwg % NXCD, xcd = wgid % NXCD, off = wgid / NXCD; wgid = (xcd < r ? xcd * (q + 1) : r * (q + 1) + (xcd - r) * q) + off; }
        const int nig = WGM * nN, gid = wgid / nig, fm = gid * WGM, gsz = (nM - fm) < WGM ? (nM - fm) : WGM;
        u.pm = fm + ((wgid % nig) % gsz); u.pn = (wgid % nig) / gsz; if (rev) u.pm = nM - 1 - u.pm; return true;
    }
};
template <int NPG> struct GroupOrder {
    int G, c;
    __device__ __forceinline__ void init(int G_, int c_) { G = G_; c = c_; }
    __device__ __forceinline__ bool next(int i, Unit& u) const {
        const long L = (long)i * G + c; if (L >= 256 * NPG) return false;
        u.pm = (int)(L / NPG); u.pn = (u.pm >> 3) * NPG + (int)(L % NPG); return true;
    }
};
struct PairOrder {
    int G, c;
    __device__ __forceinline__ void init(int G_, int c_) { G = G_; c = c_; }
    __device__ __forceinline__ bool next(int i, Unit& u) const {
        const int pm = c + (i >> 1) * G; if (pm >= 256) return false;
        u.pm = pm; u.pn = i & 1; return true;
    }
};

typedef float cvt_f32x2_t __attribute__((ext_vector_type(2)));
typedef __bf16 cvt_bf16x2_t __attribute__((ext_vector_type(2)));
__device__ __forceinline__ unsigned cvt_pk_bf16(float lo, float hi) { const cvt_f32x2_t v = {lo, hi}; const cvt_bf16x2_t b = __builtin_convertvector(v, cvt_bf16x2_t); return __builtin_bit_cast(unsigned, b); }

template <class Epi, class Sched, bool ALIGN_EPI>
__device__ __forceinline__ void gemm_phase(LAS unsigned char* lds, const Gemm g, const Sched& S, const Epi& E) {
    int tid = threadIdx.x; asm volatile("" : "+v"(tid));
    const int wid = __builtin_amdgcn_readfirstlane(tid >> 6), lane = tid & 63, wr = wid >> 2, wc = wid & 3, fr = lane & 15, fq = lane >> 4;
    const int K = g.K, nt = K / BK;
    unsigned voffA[2], voffB[2];
#pragma unroll
    for (int i = 0; i < 2; ++i) { int R, C; stage_rc(tid * 16 + i * 8192, R, C); const int Rb = Epi::PERM ? ((R & ~31) + perm32(R & 31)) : R;
        voffA[i] = (unsigned)(R * g.lda + C) * 2u; voffB[i] = (unsigned)(Rb * g.ldb + C) * 2u; }
    const size_t kstep = (size_t)(BK * 2);
    const size_t hstepA = (size_t)HALF * g.lda * 2, hstepB = (size_t)HALF * g.ldb * 2;
    const size_t tstepA = 2 * hstepA, tstepB = 2 * hstepB;
    const unsigned ldsw = (unsigned)wid * 1024u;
    const int aoff = lds_byte(wr * 64 + fr, fq * 8), boff = lds_byte(wc * 32 + fr, fq * 8);
#define PG8_SA(b, h) (((b) * 2 + (h)) * HTB)
#define PG8_SB(b, h) ((4 + (b) * 2 + (h)) * HTB)
#define PG8_STAGE(bufoff, gbase, voff) do { _Pragma("unroll") for (int _i = 0; _i < 2; ++_i) \
        __builtin_amdgcn_global_load_lds((const unsigned*)((const char*)(gbase) + (voff)[_i]), (LAS unsigned*)(lds + (bufoff) + ldsw + _i * 8192), 16, 0, 0); } while (0)
#define PG8_LDA(dst, b, h) do { _Pragma("unroll") for (int m = 0; m < 4; ++m) _Pragma("unroll") for (int k = 0; k < 2; ++k) dst[m][k] = *(const LAS bf16x8*)(lds + PG8_SA(b, h) + aoff + m * 2048 + k * 1024); } while (0)
#define PG8_LDB(dst, b, h) do { _Pragma("unroll") for (int n = 0; n < 2; ++n) _Pragma("unroll") for (int k = 0; k < 2; ++k) dst[n][k] = *(const LAS bf16x8*)(lds + PG8_SB(b, h) + boff + n * 2048 + k * 1024); } while (0)
#define PG8_MMA(ai, bj, At, Bt) do { __builtin_amdgcn_s_setprio(1); _Pragma("unroll") for (int m = 0; m < 4; ++m) _Pragma("unroll") for (int n = 0; n < 2; ++n) _Pragma("unroll") for (int k = 0; k < 2; ++k) \
        acc[ai][bj][m][n] = __builtin_amdgcn_mfma_f32_16x16x32_bf16(Bt[n][k], At[m][k], acc[ai][bj][m][n], 0, 0, 0); __builtin_amdgcn_s_setprio(0); } while (0)
#define PG8_WAIT_V(n) asm volatile("s_waitcnt vmcnt(" #n ")" ::: "memory")
#define PG8_WAIT_L(n) asm volatile("s_waitcnt lgkmcnt(" #n ")" ::: "memory")
#define PG8_BAR __builtin_amdgcn_s_barrier()
#define PG8_SCHED __builtin_amdgcn_sched_barrier(0)
    Unit cur, nxt; int ui = 0;
    if (!S.next(0, cur)) return;
    f32x4 acc[2][2][4][2];
#pragma unroll
    for (int a = 0; a < 2; ++a)
#pragma unroll
        for (int b = 0; b < 2; ++b)
#pragma unroll
            for (int m = 0; m < 4; ++m)
#pragma unroll
                for (int n = 0; n < 2; ++n) acc[a][b][m][n] = (f32x4){0.f, 0.f, 0.f, 0.f};
    bf16x8 At[4][2], B0[2][2], B1[2][2];
    const char* cA = (const char*)g.A + (size_t)cur.pm * tstepA; const char* cB = (const char*)g.Bt + (size_t)cur.pn * tstepB;
    PG8_STAGE(PG8_SB(0, 0), cB, voffB); PG8_STAGE(PG8_SB(0, 1), cB + hstepB, voffB); PG8_STAGE(PG8_SA(0, 0), cA, voffA); PG8_STAGE(PG8_SA(0, 1), cA + hstepA, voffA);
    if (wr == 1) PG8_BAR;
    PG8_WAIT_V(2); PG8_BAR;
    PG8_STAGE(PG8_SB(1, 0), cB + kstep, voffB); PG8_STAGE(PG8_SA(1, 0), cA + kstep, voffA); PG8_STAGE(PG8_SB(1, 1), cB + hstepB + kstep, voffB);
    PG8_WAIT_V(6); PG8_BAR;
    for (;;) {
        const bool has_next = S.next(ui + 1, nxt);
        const char* nA = has_next ? (const char*)g.A + (size_t)nxt.pm * tstepA : cA; const char* nB = has_next ? (const char*)g.Bt + (size_t)nxt.pn * tstepB : cB;
        for (int t = 0; t < nt; t += 2) {
            const bool last = (t == nt - 2);
            const char* a1 = cA + (size_t)(t + 1) * kstep;
            const char* a2 = last ? nA : cA + (size_t)(t + 2) * kstep; const char* b2 = last ? nB : cB + (size_t)(t + 2) * kstep;
            const char* a3 = a2 + kstep; const char* b3 = b2 + kstep;
            PG8_LDB(B0, 0, 0); PG8_LDB(B1, 0, 1); PG8_SCHED; PG8_LDA(At, 0, 0); PG8_STAGE(PG8_SA(1, 1), a1 + hstepA, voffA);
            PG8_WAIT_V(8); PG8_WAIT_L(0); PG8_BAR; PG8_MMA(0, 0, At, B0); PG8_MMA(0, 1, At, B1); PG8_BAR; PG8_SCHED;
            PG8_LDA(At, 0, 1); PG8_STAGE(PG8_SB(0, 0), b2, voffB); PG8_STAGE(PG8_SB(0, 1), b2 + hstepB, voffB); PG8_STAGE(PG8_SA(0, 0), a2, voffA);
            PG8_WAIT_V(8); PG8_WAIT_L(0); PG8_BAR; PG8_MMA(1, 0, At, B0); PG8_MMA(1, 1, At, B1); PG8_BAR; PG8_SCHED;
            PG8_LDB(B0, 1, 0); PG8_LDB(B1, 1, 1); PG8_SCHED; PG8_LDA(At, 1, 0); PG8_STAGE(PG8_SA(0, 1), a2 + hstepA, voffA);
            PG8_WAIT_V(8); PG8_WAIT_L(0); PG8_BAR; PG8_MMA(0, 0, At, B0); PG8_MMA(0, 1, At, B1); PG8_BAR; PG8_SCHED;
            PG8_LDA(At, 1, 1); PG8_STAGE(PG8_SB(1, 0), b3, voffB); PG8_STAGE(PG8_SB(1, 1), b3 + hstepB, voffB); PG8_STAGE(PG8_SA(1, 0), a3, voffA);
            PG8_WAIT_V(8); PG8_WAIT_L(0); PG8_BAR; PG8_MMA(1, 0, At, B0); PG8_MMA(1, 1, At, B1); PG8_BAR; PG8_SCHED;
        }
        if constexpr (ALIGN_EPI) { if (wr == 0) PG8_BAR; }
        if constexpr (!Epi::AFTER_DRAIN) { int fr_e = fr, fq_e = fq; asm volatile("" : "+v"(fr_e), "+v"(fq_e));
          E(acc, cur, wr, wc, fr_e, fq_e); }
        if (!has_next) break;
#pragma unroll
        for (int a = 0; a < 2; ++a)
#pragma unroll
            for (int b = 0; b < 2; ++b)
#pragma unroll
                for (int m = 0; m < 4; ++m)
#pragma unroll
                    for (int n = 0; n < 2; ++n) acc[a][b][m][n] = (f32x4){0.f, 0.f, 0.f, 0.f};
        cur = nxt; cA = nA; cB = nB; ++ui;
        if constexpr (ALIGN_EPI) { if (wr == 1) PG8_BAR; }
    }
    PG8_WAIT_V(0);
    if constexpr (!ALIGN_EPI) { if (wr == 0) PG8_BAR; }
    PG8_BAR;
    if constexpr (Epi::AFTER_DRAIN) E.fused(acc, cur, wr, wc, fr, fq, lds, tid);
#undef PG8_SA
#undef PG8_SB
#undef PG8_STAGE
#undef PG8_LDA
#undef PG8_LDB
#undef PG8_MMA
#undef PG8_WAIT_V
#undef PG8_WAIT_L
#undef PG8_BAR
#undef PG8_SCHED
}
}
using pg8::Unit; using pg8::cvt_pk_bf16;

__device__ __forceinline__ unsigned f2bf(float f);
__device__ __forceinline__ float bf_lo(unsigned u) { return __uint_as_float(u << 16); }
__device__ __forceinline__ float bf_hi(unsigned u) { return __uint_as_float(u & 0xffff0000u); }
__device__ __forceinline__ float rsq(float x) { return __builtin_amdgcn_rsqf(x); }
__device__ __forceinline__ float rcpf_(float x) { return __builtin_amdgcn_rcpf(x); }
__device__ __forceinline__ float sum4(f32x4 v) { return (v[0] + v[1]) + (v[2] + v[3]); }
__device__ __forceinline__ float sq4(f32x4 v) { return (v[0] * v[0] + v[1] * v[1]) + (v[2] * v[2] + v[3] * v[3]); }
__device__ __forceinline__ float sigmoidf_(float x) { return __builtin_amdgcn_rcpf(1.0f + __builtin_amdgcn_exp2f(-LOG2E * x)); }

__device__ __forceinline__ float row_rstd16(const float* statx, int row) {
    const f32x4* p = (const f32x4*)(statx + (size_t)row * 16);
    const f32x4 a = p[0], b = p[1], c = p[2], d = p[3];
    return rsq(((sum4(a) + sum4(b)) + (sum4(c) + sum4(d))) * (1.0f / DM) + EPS);
}

__device__ __forceinline__ void tile_rstd_to_lds(const float* statx, int row0, LAS float* rsl, int wr, int wc, int fr, int fq) {
    const int t = (wr * 4 + wc) * 64 + fq * 16 + fr;
    if (t < 256) rsl[t] = row_rstd16(statx, row0 + t);
    asm volatile("s_waitcnt lgkmcnt(0)" ::: "memory"); __builtin_amdgcn_s_barrier(); asm volatile("" ::: "memory");
}
struct EpiIn {
    static constexpr bool PERM = true; static constexpr bool AFTER_DRAIN = false;
    const float* statx; const float* shw;
    const float* gq; const float* gk;
    bf16_t* Qb; bf16_t* A3; LAS float* rsl;
    __device__ __forceinline__ void operator()(const f32x4 (&acc)[2][2][4][2], const Unit& u, int wr, int wc, int fr, int fq) const {
        const int b = u.pm >> 3, pn = u.pn;
        const int ncol0 = (pn < 4 ? 256 * pn : 1536 + 256 * (pn - 4)) + 64 * wc + 8 * fq;
        f32x4 sw[2][2];
#pragma unroll
        for (int bj = 0; bj < 2; ++bj)
#pragma unroll
            for (int n = 0; n < 2; ++n) sw[bj][n] = *(const f32x4*)(shw + (size_t)b * INC + ncol0 + 32 * bj + 4 * n);
        tile_rstd_to_lds(statx, u.pm * 256, rsl, wr, wc, fr, fq);
#pragma unroll
        for (int ai = 0; ai < 2; ++ai) {
#pragma unroll
            for (int m = 0; m < 4; ++m) {
                const int row = u.pm * 256 + ai * 128 + wr * 64 + m * 16 + fr;
                const float rs = rsl[ai * 128 + wr * 64 + m * 16 + fr];
                f32x4 v[2][2]; float ss = 0.f;
#pragma unroll
                for (int bj = 0; bj < 2; ++bj)
#pragma unroll
                    for (int n = 0; n < 2; ++n) { v[bj][n] = acc[ai][bj][m][n] * rs + sw[bj][n]; ss += sq4(v[bj][n]); }
                if (pn < 4) {
                    ss += __shfl_xor(ss, 16); ss += __shfl_xor(ss, 32);
                    const float hr = rsq(ss * (1.0f / HD) + EPS);
                    const int rrow = (u.pm & 7) * 4 + ai * 2 + wr, head = 4 * (pn & 1) + wc;
                    size_t fbase;
                    if (pn < 2) fbase = ((((size_t)(b * 32 + rrow) * 8 + head) * 4 + m) * 2) * 512 + (size_t)(fq * 16 + fr) * 8;
                    else { const int kb = m >> 1, kt = (fr >> 2) & 1, frk = ((2 * (m & 1) + (fr >> 3)) << 2) | (fr & 3);
                        fbase = (size_t)NTOK * AW + ((((((size_t)(b * 32 + rrow) * 8 + head) * 2 + kb) * 2 + kt) * 2) * 512) + (size_t)(fq * 16 + frk) * 8; }
                    bf16_t* dst = Qb + fbase;
#pragma unroll
                    for (int bj = 0; bj < 2; ++bj) {
                        f32x4 a = v[bj][0] * hr, c = v[bj][1] * hr;
                        if (pn < 2) { const int d = 32 * bj + 8 * fq; a = a * (*(const f32x4*)(gq + d) * *(const f32x4*)(gk + d) * (0.125f * LOG2E)); c = c * (*(const f32x4*)(gq + d + 4) * *(const f32x4*)(gk + d + 4) * (0.125f * LOG2E)); }
                        u32x4 w; w.x = cvt_pk_bf16(a[0], a[1]); w.y = cvt_pk_bf16(a[2], a[3]); w.z = cvt_pk_bf16(c[0], c[1]); w.w = cvt_pk_bf16(c[2], c[3]);
                        *(u32x4*)(dst + 512 * bj) = w;
                    }
                } else {
                    const int tl = row & (SEQ - 1), ch = tl >> 5, s = tl & 31;
#pragma unroll
                    for (int bj = 0; bj < 2; ++bj) {
                        const int cu = 256 * (pn - 4) + 64 * wc + 32 * bj + 8 * fq;
                        const int gidx = cu >> 4, half = (cu >> 3) & 1;
                        bf16_t* dst = A3 + ((size_t)gidx * 2048 + b * NCH + ch) * 768 + s * 16 + 8 * half;
                        u32x4 w; w.x = cvt_pk_bf16(v[bj][0][0], v[bj][0][1]); w.y = cvt_pk_bf16(v[bj][0][2], v[bj][0][3]); w.z = cvt_pk_bf16(v[bj][1][0], v[bj][1][1]); w.w = cvt_pk_bf16(v[bj][1][2], v[bj][1][3]);
                        *(u32x4*)dst = w;
                    }
                }
            }
        }
    }
};
struct EpiVt {
    static constexpr bool PERM = true; static constexpr bool AFTER_DRAIN = false;
    const float* statx; const float* shw; bf16_t* VT; LAS float* rsl;
    __device__ __forceinline__ void operator()(const f32x4 (&acc)[2][2][4][2], const Unit& u, int wr, int wc, int fr, int fq) const {
        const int b = u.pn >> 3, t0 = (u.pn & 7) * 256 + wc * 32 + 8 * fq;
        tile_rstd_to_lds(statx, u.pn * 256, rsl, wr, wc, fr, fq);
        float rs[2][8];
#pragma unroll
        for (int bj = 0; bj < 2; ++bj) { const f32x4 r0_ = *(const LAS f32x4*)(rsl + 128 * bj + wc * 32 + 8 * fq), r1_ = *(const LAS f32x4*)(rsl + 128 * bj + wc * 32 + 8 * fq + 4);
            rs[bj][0] = r0_[0]; rs[bj][1] = r0_[1]; rs[bj][2] = r0_[2]; rs[bj][3] = r0_[3]; rs[bj][4] = r1_[0]; rs[bj][5] = r1_[1]; rs[bj][6] = r1_[2]; rs[bj][7] = r1_[3]; }
#pragma unroll
        for (int ai = 0; ai < 2; ++ai)
#pragma unroll
            for (int m = 0; m < 4; ++m) {
                const int cv = u.pm * 256 + ai * 128 + wr * 64 + m * 16 + fr;
                const float sh = shw[(size_t)b * INC + 1024 + cv];
                const int head = u.pm * 4 + ai * 2 + wr;
#pragma unroll
                for (int bj = 0; bj < 2; ++bj) {
                    const int rrow = (u.pn & 7) * 4 + bj * 2 + (wc >> 1), kb = wc & 1;
                    bf16_t* dst = VT + (((((size_t)(b * 32 + rrow) * 8 + head) * 2 + kb) * 4 + m) * 512) + (size_t)(fq * 16 + fr) * 8;
                    const f32x4 a = acc[ai][bj][m][0], c = acc[ai][bj][m][1];
                    u32x4 w; w.x = cvt_pk_bf16(a[0] * rs[bj][0] + sh, a[1] * rs[bj][1] + sh); w.y = cvt_pk_bf16(a[2] * rs[bj][2] + sh, a[3] * rs[bj][3] + sh);
                    w.z = cvt_pk_bf16(c[0] * rs[bj][4] + sh, c[1] * rs[bj][5] + sh); w.w = cvt_pk_bf16(c[2] * rs[bj][6] + sh, c[3] * rs[bj][7] + sh);
                    *(u32x4*)dst = w;
                }
            }
    }
};
struct EpiS1 {
    static constexpr bool PERM = false; static constexpr bool AFTER_DRAIN = false;
    float* L;
    __device__ __forceinline__ void operator()(const f32x4 (&acc)[2][2][4][2], const Unit& u, int wr, int wc, int fr, int fq) const {
#pragma unroll
        for (int ai = 0; ai < 2; ++ai)
#pragma unroll
            for (int m = 0; m < 4; ++m) {
                float* rowp = L + (size_t)(u.pm * 256 + ai * 128 + wr * 64 + m * 16 + fr) * 256 + wc * 32 + 4 * fq;
#pragma unroll
                for (int bj = 0; bj < 2; ++bj)
#pragma unroll
                    for (int n = 0; n < 2; ++n) *(f32x4*)(rowp + 128 * bj + 16 * n) = acc[ai][bj][m][n];
            }
    }
};
struct EpiS1F {
    static constexpr bool PERM = false; static constexpr bool AFTER_DRAIN = true;
    const f32x2* pwl;
    bf16_t* A3;
    __device__ __forceinline__ void operator()(const f32x4 (&)[2][2][4][2], const Unit&, int, int, int, int) const {}
    __device__ __forceinline__ void fused(const f32x4 (&acc)[2][2][4][2], const Unit& u, int wr, int wc, int fr, int fq, LAS unsigned char* lds, int tid) const {
        LAS float* T = (LAS float*)lds;
        const int gi = u.pm >> 3;
#pragma unroll
        for (int half = 0; half < 2; ++half) {
#pragma unroll
            for (int m = 0; m < 4; ++m)
#pragma unroll
                for (int bj = 0; bj < 2; ++bj)
#pragma unroll
                    for (int n = 0; n < 2; ++n) *(LAS f32x4*)(T + (wr * 64 + m * 16 + fr) * 260 + 128 * bj + 32 * wc + 16 * n + 4 * fq) = acc[half][bj][m][n];
            asm volatile("s_waitcnt lgkmcnt(0)" ::: "memory"); __builtin_amdgcn_s_barrier(); asm volatile("" ::: "memory");
            if (tid < 256) {
                const int bb = tid >> 7, dir = (tid >> 6) & 1, p = tid & 63, b = 4 * (u.pm & 7) + 2 * half + bb;
                const f32x2 w = pwl[((size_t)(dir * 32 + gi) * 33 + 32) * 64 + p];
                float hr = 0.f, hi_ = 0.f;
                bf16_t* abase = A3 + ((size_t)gi * 2048 + b * NCH) * 768 + 512 + dir * 128 + p;
                const LAS float* tb_ = T + (bb * 64) * 260 + dir * 128 + p;
#pragma unroll 8
                for (int cc = 0; cc < NCH; ++cc) { const int ch = dir == 0 ? cc : NCH - 1 - cc;
                    bf16_t* ap = abase + (size_t)ch * 768; ap[0] = (bf16_t)f2bf(hr); ap[64] = (bf16_t)f2bf(hi_);
                    const float lr = tb_[ch * 260], li = tb_[ch * 260 + 64];
                    const float nr = w.x * hr - w.y * hi_ + lr, ni = w.x * hi_ + w.y * hr + li; hr = nr; hi_ = ni; }
            }
            asm volatile("s_waitcnt lgkmcnt(0)" ::: "memory"); __builtin_amdgcn_s_barrier(); asm volatile("" ::: "memory");
        }
    }
};
__device__ __forceinline__ float gelu_tanh(float y) {
    const float t = 1.5957691216057308f * (y + 0.044715f * y * y * y);
    return y * __builtin_amdgcn_rcpf(1.0f + __builtin_amdgcn_exp2f(-LOG2E * t));
}
struct EpiS3 {
    static constexpr bool PERM = true; static constexpr bool AFTER_DRAIN = false;
    bf16_t* Z;
    __device__ __forceinline__ void operator()(const f32x4 (&acc)[2][2][4][2], const Unit& u, int wr, int wc, int fr, int fq) const {
        const int gidx = u.pm >> 3;
#pragma unroll
        for (int ai = 0; ai < 2; ++ai)
#pragma unroll
            for (int m = 0; m < 4; ++m) {
                const int bc = (u.pm & 7) * 256 + ai * 128 + wr * 64 + m * 16 + fr, b = bc >> 6, ch = bc & 63;
#pragma unroll
                for (int bj = 0; bj < 2; ++bj) {
                    const int nl = (u.pn & 1) * 256 + bj * 128 + wc * 32 + 8 * fq, tau = nl >> 4, c8 = nl & 15;
                    const f32x4 a = acc[ai][bj][m][0], c = acc[ai][bj][m][1];
                    u32x4 w; w.x = cvt_pk_bf16(gelu_tanh(a[0]), gelu_tanh(a[1])); w.y = cvt_pk_bf16(gelu_tanh(a[2]), gelu_tanh(a[3]));
                    w.z = cvt_pk_bf16(gelu_tanh(c[0]), gelu_tanh(c[1])); w.w = cvt_pk_bf16(gelu_tanh(c[2]), gelu_tanh(c[3]));
                    *(u32x4*)(Z + (size_t)(b * SEQ + ch * CT + tau) * SW + gidx * 16 + c8) = w;
                }
            }
    }
};
struct EpiGlu {
    static constexpr bool PERM = true; static constexpr bool AFTER_DRAIN = false;
    const bf16_t* Z; const float* gs; float* stats; bf16_t* MIX;
    __device__ __forceinline__ void operator()(const f32x4 (&acc)[2][2][4][2], const Unit& u, int wr, int wc, int fr, int fq) const {
        const int col0 = u.pn * 256 + wc * 32 + 8 * fq;
        f32x4 gv[2][2];
#pragma unroll
        for (int bj = 0; bj < 2; ++bj)
#pragma unroll
            for (int n = 0; n < 2; ++n) gv[bj][n] = *(const f32x4*)(gs + col0 + 128 * bj + 4 * n);
#pragma unroll
        for (int ai = 0; ai < 2; ++ai) {
            u32x4 zpre[4][2];
#pragma unroll
            for (int m = 0; m < 4; ++m)
#pragma unroll
                for (int bj = 0; bj < 2; ++bj) zpre[m][bj] = *(const u32x4*)(Z + (size_t)(u.pm * 256 + ai * 128 + wr * 64 + m * 16 + fr) * SW + col0 + 128 * bj);
            asm volatile("" ::: "memory");
#pragma unroll
            for (int m = 0; m < 4; ++m) {
                const int row = u.pm * 256 + ai * 128 + wr * 64 + m * 16 + fr;
                float ss = 0.f;
#pragma unroll
                for (int bj = 0; bj < 2; ++bj) {
                    const u32x4 zz = zpre[m][bj];
                    const f32x4 a = acc[ai][bj][m][0], c = acc[ai][bj][m][1];
                    f32x4 o0, o1;
                    o0[0] = bf_lo(zz.x) * sigmoidf_(a[0]); o0[1] = bf_hi(zz.x) * sigmoidf_(a[1]); o0[2] = bf_lo(zz.y) * sigmoidf_(a[2]); o0[3] = bf_hi(zz.y) * sigmoidf_(a[3]);
                    o1[0] = bf_lo(zz.z) * sigmoidf_(c[0]); o1[1] = bf_hi(zz.z) * sigmoidf_(c[1]); o1[2] = bf_lo(zz.w) * sigmoidf_(c[2]); o1[3] = bf_hi(zz.w) * sigmoidf_(c[3]);
                    ss += sq4(o0) + sq4(o1);
                    o0 = o0 * gv[bj][0]; o1 = o1 * gv[bj][1];
                    u32x4 w; w.x = cvt_pk_bf16(o0[0], o0[1]); w.y = cvt_pk_bf16(o0[2], o0[3]); w.z = cvt_pk_bf16(o1[0], o1[1]); w.w = cvt_pk_bf16(o1[2], o1[3]);
                    *(u32x4*)(MIX + (size_t)row * DM + AW + col0 + 128 * bj) = w;
                }
                ss += __shfl_xor(ss, 16); ss += __shfl_xor(ss, 32);
                if (fq == 0) stats[(size_t)row * 8 + u.pn * 4 + wc] = ss;
            }
        }
    }
};
struct EpiRes {
    static constexpr bool PERM = true; static constexpr bool AFTER_DRAIN = false;
    const float* xin; float* xout; const float* gate; int gate_ld;
    const float* gmn; bf16_t* AX; float* statx;
    LAS float* gl;
    __device__ __forceinline__ void operator()(const f32x4 (&acc)[2][2][4][2], const Unit& u, int wr, int wc, int fr, int fq) const {
        const int b = u.pm >> 3, col0 = u.pn * 256 + wc * 32 + 8 * fq;
        { const int t = (wr * 4 + wc) * 64 + fq * 16 + fr;
          if (t < 64) ((LAS f32x4*)gl)[t] = *(const f32x4*)(gate + (size_t)b * gate_ld + u.pn * 256 + 4 * t);
          else if (t < 128 && gmn) ((LAS f32x4*)gl)[t] = *(const f32x4*)(gmn + (size_t)b * DM + u.pn * 256 + 4 * (t - 64));
          asm volatile("s_waitcnt vmcnt(0) lgkmcnt(0)" ::: "memory"); __builtin_amdgcn_s_barrier(); asm volatile("" ::: "memory"); }
        const LAS float* gtp = gl + wc * 32 + 8 * fq; const LAS float* gmp = gl + 256 + wc * 32 + 8 * fq;
#pragma unroll
        for (int ai = 0; ai < 2; ++ai) {
            f32x4 xr[4][2][2];
#pragma unroll
            for (int m = 0; m < 4; ++m) { const size_t off = (size_t)(u.pm * 256 + ai * 128 + wr * 64 + m * 16 + fr) * DM + col0;
#pragma unroll
                for (int bj = 0; bj < 2; ++bj)
#pragma unroll
                    for (int n = 0; n < 2; ++n) xr[m][bj][n] = *(const f32x4*)(xin + off + 128 * bj + 4 * n); }
            asm volatile("" ::: "memory");
#pragma unroll
            for (int m = 0; m < 4; ++m) {
                const int row = u.pm * 256 + ai * 128 + wr * 64 + m * 16 + fr;
                const size_t off = (size_t)row * DM + col0;
                float ss = 0.f;
#pragma unroll
                for (int bj = 0; bj < 2; ++bj) {
                    const f32x4 xo0 = xr[m][bj][0] + *(const LAS f32x4*)(gtp + 128 * bj) * acc[ai][bj][m][0], xo1 = xr[m][bj][1] + *(const LAS f32x4*)(gtp + 128 * bj + 4) * acc[ai][bj][m][1];
                    *(f32x4*)(xout + off + 128 * bj) = xo0; *(f32x4*)(xout + off + 128 * bj + 4) = xo1;
                    if (gmn) { ss += sq4(xo0) + sq4(xo1); const f32x4 a = xo0 * *(const LAS f32x4*)(gmp + 128 * bj), c = xo1 * *(const LAS f32x4*)(gmp + 128 * bj + 4);
                        u32x4 w; w.x = cvt_pk_bf16(a[0], a[1]); w.y = cvt_pk_bf16(a[2], a[3]); w.z = cvt_pk_bf16(c[0], c[1]); w.w = cvt_pk_bf16(c[2], c[3]); *(u32x4*)(AX + off + 128 * bj) = w; }
                }
                if (gmn) { ss += __shfl_xor(ss, 16); ss += __shfl_xor(ss, 32); if (fq == 0) statx[(size_t)row * 16 + u.pn * 4 + wc] = ss; }
            }
        }
    }
};
struct EpiMlp1 {
    static constexpr bool PERM = true; static constexpr bool AFTER_DRAIN = false;
    const float* statx; const float* shw; bf16_t* H; LAS float* rsl;
    __device__ __forceinline__ void operator()(const f32x4 (&acc)[2][2][4][2], const Unit& u, int wr, int wc, int fr, int fq) const {
        const int b = u.pm >> 3, col0 = u.pn * 256 + wc * 32 + 8 * fq;
        f32x4 sw[2][2];
#pragma unroll
        for (int bj = 0; bj < 2; ++bj)
#pragma unroll
            for (int n = 0; n < 2; ++n) sw[bj][n] = *(const f32x4*)(shw + (size_t)b * DFF + col0 + 128 * bj + 4 * n);
        tile_rstd_to_lds(statx, u.pm * 256, rsl, wr, wc, fr, fq);
#pragma unroll
        for (int ai = 0; ai < 2; ++ai)
#pragma unroll
            for (int m = 0; m < 4; ++m) {
                const int row = u.pm * 256 + ai * 128 + wr * 64 + m * 16 + fr;
                const float rs = rsl[ai * 128 + wr * 64 + m * 16 + fr];
#pragma unroll
                for (int bj = 0; bj < 2; ++bj) {
                    f32x4 a = acc[ai][bj][m][0] * rs + sw[bj][0], c = acc[ai][bj][m][1] * rs + sw[bj][1];
#pragma unroll
                    for (int e = 0; e < 4; ++e) { a[e] = fmaxf(a[e], 0.f); a[e] *= a[e]; c[e] = fmaxf(c[e], 0.f); c[e] *= c[e]; }
                    u32x4 w; w.x = cvt_pk_bf16(a[0], a[1]); w.y = cvt_pk_bf16(a[2], a[3]); w.z = cvt_pk_bf16(c[0], c[1]); w.w = cvt_pk_bf16(c[2], c[3]);
                    *(u32x4*)(H + (size_t)row * DFF + col0 + 128 * bj) = w;
                }
            }
    }
};

struct Args { const float* in[24]; float* out; unsigned char* ws; int ph_lo, ph_hi; };
constexpr int LDS_BYTES = 147456;
constexpr int NPH = 3 + 8 * DEPTH;

__device__ __forceinline__ float wave_sum(float v) {
#pragma unroll
    for (int o = 1; o < 64; o <<= 1) v += __shfl_xor(v, o);
    return v;
}
__device__ __forceinline__ unsigned f2bf(float f) { unsigned u = __float_as_uint(f); return (u + 0x7fffu + ((u >> 16) & 1u)) >> 16; }
__device__ __forceinline__ unsigned pk2(float lo, float hi) { return f2bf(lo) | (f2bf(hi) << 16); }

__device__ __forceinline__ void transpose_item(const float* W, int N, int ksrc0, int nsrc0, bf16_t* WT, int ldt, int drow0, int kdst0, LAS float* scr, int lane) {
    float tv[32];
#pragma unroll
    for (int i = 0; i < 32; ++i) { const int kk = 2 * i + (lane >> 5); tv[i] = W[(size_t)(ksrc0 + kk) * N + nsrc0 + (lane & 31)]; }
#pragma unroll
    for (int i = 0; i < 32; ++i) { const int kk = 2 * i + (lane >> 5); scr[kk * 33 + (lane & 31)] = tv[i]; }
    asm volatile("s_waitcnt lgkmcnt(0)" ::: "memory");
    const int c = lane & 7;
#pragma unroll
    for (int j = 0; j < 4; ++j) { const int n = (lane >> 3) + 8 * j; const LAS float* s = scr + (8 * c) * 33 + n;
        u32x4 o; o.x = pk2(s[0 * 33], s[1 * 33]); o.y = pk2(s[2 * 33], s[3 * 33]); o.z = pk2(s[4 * 33], s[5 * 33]); o.w = pk2(s[6 * 33], s[7 * 33]);
        *(u32x4*)(WT + (size_t)(drow0 + n) * ldt + kdst0 + 8 * c) = o; }
    asm volatile("s_waitcnt lgkmcnt(0)" ::: "memory");
}

typedef float f32x16 __attribute__((ext_vector_type(16)));
constexpr int S16_LD = 1032;
__device__ __forceinline__ void gemv32_task(LAS unsigned char* ldsb, const float* W, int N, int col0, const float* bias, float* out, int out_ld, int tid) {
    const int wave = tid >> 6, lane = tid & 63, n = lane & 31, kh = lane >> 5;
    const LAS bf16_t* S16 = (const LAS bf16_t*)ldsb;
    f32x16 acc0, acc1;
#pragma unroll
    for (int e = 0; e < 16; ++e) { acc0[e] = 0.f; acc1[e] = 0.f; }
    const float* wp = W + (size_t)(wave * 128 + 8 * kh) * N + col0 + n;
#pragma unroll 1
    for (int ks = 0; ks < 8; ks += 2) {
        float w0[2][8], w1[2][8];
#pragma unroll
        for (int q = 0; q < 2; ++q)
#pragma unroll
            for (int j = 0; j < 8; ++j) { w0[q][j] = wp[(size_t)((ks + q) * 16 + j) * N]; w1[q][j] = wp[(size_t)((ks + q) * 16 + j) * N + 32]; }
#pragma unroll
        for (int q = 0; q < 2; ++q) {
            const bf16x8 a = *(const LAS bf16x8*)(S16 + n * S16_LD + wave * 128 + (ks + q) * 16 + 8 * kh);
            union { u32x4 u; bf16x8 v; } b0, b1;
            b0.u.x = pk2(w0[q][0], w0[q][1]); b0.u.y = pk2(w0[q][2], w0[q][3]); b0.u.z = pk2(w0[q][4], w0[q][5]); b0.u.w = pk2(w0[q][6], w0[q][7]);
            b1.u.x = pk2(w1[q][0], w1[q][1]); b1.u.y = pk2(w1[q][2], w1[q][3]); b1.u.z = pk2(w1[q][4], w1[q][5]); b1.u.w = pk2(w1[q][6], w1[q][7]);
            acc0 = __builtin_amdgcn_mfma_f32_32x32x16_bf16(a, b0.v, acc0, 0, 0, 0);
            acc1 = __builtin_amdgcn_mfma_f32_32x32x16_bf16(a, b1.v, acc1, 0, 0, 0);
        }
    }
    __syncthreads();
    LAS float* red = (LAS float*)ldsb;
#pragma unroll
    for (int e = 0; e < 16; ++e) { const int row = (e & 3) + 8 * (e >> 2) + 4 * kh;
        red[(wave * 32 + row) * 64 + n] = acc0[e]; red[(wave * 32 + row) * 64 + 32 + n] = acc1[e]; }
    __syncthreads();
    for (int o = tid; o < 2048; o += 512) { const int b = o >> 6, l = o & 63; float s = bias ? bias[col0 + l] : 0.f;
#pragma unroll
        for (int w = 0; w < 8; ++w) s += red[(w * 32 + b) * 64 + l];
        out[(size_t)b * out_ld + col0 + l] = s; }
    __syncthreads();
}

__device__ __forceinline__ void dsincos_red(double x, double& s, double& c) {
    const double TWO_PI = 6.283185307179586476925, INV = 0.15915494309189533577;
    const double k = rint(x * INV); x = x - k * TWO_PI;
    const double x2 = x * x; double ts = 1.0, tc = 1.0;
#pragma unroll 1
    for (int n = 31; n >= 3; n -= 2) { ts = 1.0 - ts * x2 / (double)(n * (n - 1)); }
#pragma unroll 1
    for (int n = 30; n >= 2; n -= 2) { tc = 1.0 - tc * x2 / (double)(n * (n - 1)); }
    s = x * ts; c = tc;
}
__device__ __forceinline__ double dexp_small(double x) { double t = 1.0;
#pragma unroll 1
    for (int n = 14; n >= 1; --n) t = 1.0 + t * x / (double)n;
    return t; }

__device__ __forceinline__ void attn_phase(LAS unsigned char* lds, const bf16_t* Qb, const bf16_t* Kb, const bf16_t* VT, bf16_t* MIX,
                                           const float* tblg, const float* ga) {
    int tid = threadIdx.x; asm volatile("" : "+v"(tid));
    const int h = __builtin_amdgcn_readfirstlane(tid >> 6), lane = tid & 63, fr = lane & 15, fq = lane >> 4;
    LAS float* tbl = (LAS float*)lds;
    LAS float* red = (LAS float*)(lds + 61440);
#pragma unroll
    for (int i4 = 0; i4 < 8; ++i4) { const int i = tid + 512 * i4; if (i < NH * 15 * 128 / 4) ((LAS f32x4*)tbl)[i] = ((const f32x4*)tblg)[i]; }
    __syncthreads();
    LAS u32x4* mskl = (LAS u32x4*)(lds + 63488);
    if (h == 0) {
#pragma unroll
        for (int qt = 0; qt < 4; ++qt)
#pragma unroll
            for (int kb = 0; kb < 2; ++kb) {
                if ((qt == 0 && kb == 1) || (qt == 3 && kb == 0)) continue;
                const int bi = qt == 0 ? 0 : (qt == 1 ? 1 + kb : (qt == 2 ? 3 + kb : 5));
                const int qc = 16 * qt + fr, cs = min(max(qc - 8, 0), 48), d = 32 * kb + 8 * fq - cs;
                u32x4 mm;
                mm.x = (((unsigned)(d + 0) < 16u) ? 0xffffu : 0u) | (((unsigned)(d + 1) < 16u) ? 0xffff0000u : 0u);
                mm.y = (((unsigned)(d + 2) < 16u) ? 0xffffu : 0u) | (((unsigned)(d + 3) < 16u) ? 0xffff0000u : 0u);
                mm.z = (((unsigned)(d + 4) < 16u) ? 0xffffu : 0u) | (((unsigned)(d + 5) < 16u) ? 0xffff0000u : 0u);
                mm.w = (((unsigned)(d + 6) < 16u) ? 0xffffu : 0u) | (((unsigned)(d + 7) < 16u) ? 0xffff0000u : 0u);
                mskl[bi * 64 + lane] = mm;
            }
    }
    __syncthreads();
    const bool xmap = (gridDim.x == 256);
    for (int ui = 0, unit = blockIdx.x; unit < NB * 32; unit += gridDim.x, ++ui) {
        const int b = xmap ? (int)(blockIdx.x & 7) + 8 * ui : unit >> 5, r = xmap ? (int)(blockIdx.x >> 3) : unit & 31;
        const int r0 = min(max(r - 4, 0), 24);
        LAS bf16x8* qlds = (LAS bf16x8*)(lds + 69632 + h * 8192);
        {
            const bf16_t* qbase = Qb + (((size_t)(b * 32 + r) * 8 + h) * 8) * 512 + lane * 8;
#pragma unroll
            for (int qt = 0; qt < 4; ++qt)
#pragma unroll
                for (int ks = 0; ks < 2; ++ks) qlds[(qt * 2 + ks) * 64 + lane] = *(const bf16x8*)(qbase + (qt * 2 + ks) * 512);
        }
        f32x4 O[4][4]; float l[4];
#pragma unroll
        for (int qt = 0; qt < 4; ++qt) { l[qt] = 0.f;
#pragma unroll
            for (int nt = 0; nt < 4; ++nt) O[qt][nt] = (f32x4){0.f, 0.f, 0.f, 0.f}; }
        const bf16_t* kbase0 = Kb + (((size_t)(b * 32 + r0) * 8 + h) * 8) * 512 + lane * 8;
        const bf16_t* vbase0 = VT + (((size_t)(b * 32 + r0) * 8 + h) * 8) * 512 + lane * 8;
        bf16x8 kA[2][2], vA[4], kB[2][2], vB[4];
#define ATT_LOADH(KF, VF, jj, kb_) do { \
            _Pragma("unroll") for (int kt = 0; kt < 2; ++kt) _Pragma("unroll") for (int ks = 0; ks < 2; ++ks) KF[kt][ks] = *(const bf16x8*)(kbase0 + (size_t)(jj) * (8 * 8 * 512) + (((kb_) * 2 + kt) * 2 + ks) * 512); \
            _Pragma("unroll") for (int nt = 0; nt < 4; ++nt) VF[nt] = *(const bf16x8*)(vbase0 + (size_t)(jj) * (8 * 8 * 512) + ((kb_) * 4 + nt) * 512); } while (0)
#define ATT_HALF(KF, VF, kb_) do { \
            f32x4 s0_[3], s1_[3]; union { u32x4 u; bf16x8 v; } pf_[3]; \
            _Pragma("unroll") for (int q3 = 0; q3 < 3; ++q3) { const int qt = (kb_) + q3; \
                const bf16x8 qf0 = qlds[(qt * 2 + 0) * 64 + lane], qf1 = qlds[(qt * 2 + 1) * 64 + lane]; \
                { const LAS float* tb = trow + (32 * (kb_) + 8 * fq - (16 * qt + fr) + 15 + 48); s0_[q3] = (f32x4){tb[0], tb[1], tb[2], tb[3]}; s1_[q3] = (f32x4){tb[4], tb[5], tb[6], tb[7]}; } \
                s0_[q3] = __builtin_amdgcn_mfma_f32_16x16x32_bf16(KF[0][0], qf0, s0_[q3], 0, 0, 0); \
                s1_[q3] = __builtin_amdgcn_mfma_f32_16x16x32_bf16(KF[1][0], qf0, s1_[q3], 0, 0, 0); \
                s0_[q3] = __builtin_amdgcn_mfma_f32_16x16x32_bf16(KF[0][1], qf1, s0_[q3], 0, 0, 0); \
                s1_[q3] = __builtin_amdgcn_mfma_f32_16x16x32_bf16(KF[1][1], qf1, s1_[q3], 0, 0, 0); } \
            _Pragma("unroll") for (int q3 = 0; q3 < 3; ++q3) { const int qt = (kb_) + q3; \
                const int bi = qt == 0 ? 0 : (qt == 1 ? 1 + (kb_) : (qt == 2 ? 3 + (kb_) : 5)); \
                float p[8]; \
                _Pragma("unroll") for (int i = 0; i < 8; ++i) p[i] = __builtin_amdgcn_exp2f(i < 4 ? s0_[q3][i & 3] : s1_[q3][i & 3]); \
                const u32x4 mm = mskl[bi * 64 + lane]; \
                pf_[q3].u.x = cvt_pk_bf16(p[0], p[1]) & mm.x; pf_[q3].u.y = cvt_pk_bf16(p[2], p[3]) & mm.y; pf_[q3].u.z = cvt_pk_bf16(p[4], p[5]) & mm.z; pf_[q3].u.w = cvt_pk_bf16(p[6], p[7]) & mm.w; } \
            _Pragma("unroll") for (int q3 = 0; q3 < 3; ++q3) { const int qt = (kb_) + q3; \
                _Pragma("unroll") for (int nt = 0; nt < 4; ++nt) O[qt][nt] = __builtin_amdgcn_mfma_f32_16x16x32_bf16(VF[nt], pf_[q3].v, O[qt][nt], 0, 0, 0); \
                asm("v_dot2c_f32_bf16 %0, %1, %2" : "+v"(l[qt]) : "v"(0x3F803F80u), "v"(pf_[q3].u.x)); \
                asm("v_dot2c_f32_bf16 %0, %1, %2" : "+v"(l[qt]) : "v"(0x3F803F80u), "v"(pf_[q3].u.y)); \
                asm("v_dot2c_f32_bf16 %0, %1, %2" : "+v"(l[qt]) : "v"(0x3F803F80u), "v"(pf_[q3].u.z)); \
                asm("v_dot2c_f32_bf16 %0, %1, %2" : "+v"(l[qt]) : "v"(0x3F803F80u), "v"(pf_[q3].u.w)); } \
            } while (0)
        ATT_LOADH(kA, vA, 0, 0);
#pragma unroll 1
        for (int j = 0; j < 8; ++j) {
            const int dr = r0 + j - r + 7;
            const LAS float* trow = tbl + (h * 15 + dr) * 128;
            ATT_LOADH(kB, vB, j, 1);
            ATT_HALF(kA, vA, 0);
            { const int jn = j < 7 ? j + 1 : 7; ATT_LOADH(kA, vA, jn, 0); }
            ATT_HALF(kB, vB, 1);
        }
#undef ATT_LOADH
#undef ATT_HALF
        float ssq[4];
#pragma unroll
        for (int qt = 0; qt < 4; ++qt) {
            float lt = l[qt]; lt += __shfl_xor(lt, 16); lt += __shfl_xor(lt, 32);
            const float inv = __builtin_amdgcn_rcpf(lt); float ss = 0.f;
#pragma unroll
            for (int nt = 0; nt < 4; ++nt) { O[qt][nt] = O[qt][nt] * inv; ss += sq4(O[qt][nt]); }
            ss += __shfl_xor(ss, 16); ss += __shfl_xor(ss, 32);
            ssq[qt] = ss;
            if (fq == 0) red[h * 64 + 16 * qt + fr] = ss;
        }
        __syncthreads();
#pragma unroll
        for (int qt = 0; qt < 4; ++qt) {
            float tot = 0.f;
#pragma unroll
            for (int w = 0; w < 8; ++w) tot += red[w * 64 + 16 * qt + fr];
            const float rs = rsq(tot * (1.0f / AW) + EPS);
            bf16_t* op = MIX + (size_t)(b * SEQ + r * 64 + 16 * qt + fr) * DM + h * 64 + 4 * fq;
#pragma unroll
            for (int nt = 0; nt < 4; ++nt) { const f32x4 g4 = *(const f32x4*)(ga + h * 64 + 16 * nt + 4 * fq); const f32x4 a = O[qt][nt] * rs * g4;
                u32x2 w; w.x = cvt_pk_bf16(a[0], a[1]); w.y = cvt_pk_bf16(a[2], a[3]); *(u32x2*)(op + 16 * nt) = w; }
        }
        __syncthreads();
    }
}

#define XB_TMO      128
#define XB_XCNT(j)  (256  + 64 * (j))
#define XB_XSUB(j)  (1280 + 64 * (j))
#define XB_XGEN(j)  (2304 + 64 * (j))
#define XB_TOP      3328
#define XB_TOPGEN   3392
#define XCD_BAR_WORDS 3456
#define XB_SPIN_CAP (1u << 22)

__device__ __forceinline__ unsigned xb_ld(unsigned* p)              { return __hip_atomic_load(p, __ATOMIC_RELAXED, __HIP_MEMORY_SCOPE_AGENT); }
__device__ __forceinline__ unsigned xb_add(unsigned* p, unsigned v) { return __hip_atomic_fetch_add(p, v, __ATOMIC_RELAXED, __HIP_MEMORY_SCOPE_AGENT); }
__device__ __forceinline__ unsigned xb_xcc_id() { return (unsigned)__builtin_amdgcn_s_getreg((3 << 11) | 20) & 0xFu; }
#define XB_SPIN(cond, bar) do { unsigned _sp = 0; while (cond) { __builtin_amdgcn_s_sleep(1); \
    if ((++_sp & 255u) == 0u) { if (xb_ld(&(bar)[XB_TMO])) break; if (_sp > XB_SPIN_CAP) { atomicAdd(&(bar)[XB_TMO], 1u); break; } } } } while (0)

struct XcdBarrier {
    unsigned* bar; unsigned x;
    volatile LAS unsigned* st;
};

__device__ __forceinline__ XcdBarrier xcd_barrier_post(unsigned* bar, volatile LAS unsigned* st) {
    XcdBarrier b; b.bar = bar; b.x = xb_xcc_id(); b.st = st;
    if (threadIdx.x == 0) (void)xb_add(&bar[XB_XCNT(b.x)], 1u);
    return b;
}
__device__ __forceinline__ void xcd_barrier_complete(unsigned* bar, unsigned x, unsigned& nloc, unsigned& nx) {
    const unsigned G = gridDim.x * gridDim.y * gridDim.z;
    unsigned sum, cnt, mine, sp = 0u;
    for (;;) {
        sum = 0u; cnt = 0u; mine = 0u;
#pragma unroll
        for (unsigned j = 0; j < 16; ++j) { const unsigned c = xb_ld(&bar[XB_XCNT(j)]); sum += c; cnt += (c > 0u) ? 1u : 0u; mine = (j == x) ? c : mine; }
        if (sum == G) break;
        __builtin_amdgcn_s_sleep(1);
        if ((++sp & 255u) == 0u) { if (xb_ld(&bar[XB_TMO])) break; if (sp > XB_SPIN_CAP) { atomicAdd(&bar[XB_TMO], 1u); break; } }
    }
    nloc = mine > 0u ? mine : 1u; nx = cnt > 0u ? cnt : 1u;
}

__device__ __forceinline__ void xcd_barrier(const XcdBarrier& b) {
    asm volatile("s_waitcnt vmcnt(0)" ::: "memory");
    __syncthreads();
    if (threadIdx.x == 0) {
        unsigned* bar = b.bar;
        __builtin_amdgcn_s_waitcnt(0);
        unsigned nloc = b.st[0], nx = b.st[1];
        if (nloc == 0u) { xcd_barrier_complete(bar, b.x, nloc, nx); b.st[0] = nloc; b.st[1] = nx; }
        const unsigned old = xb_add(&bar[XB_XSUB(b.x)], 1u);
        const unsigned gen = old / nloc;
        if (old + 1u == (gen + 1u) * nloc) {
            __builtin_amdgcn_fence(__ATOMIC_RELEASE, "agent");
            asm volatile("s_waitcnt vmcnt(0)" ::: "memory");
            const unsigned og = xb_add(&bar[XB_TOP], 1u);
            const unsigned tg = og / nx;
            if (og + 1u == (tg + 1u) * nx) xb_add(&bar[XB_TOPGEN], 1u);
            else XB_SPIN(xb_ld(&bar[XB_TOPGEN]) == tg, bar);
            __builtin_amdgcn_fence(__ATOMIC_ACQUIRE, "agent");
            xb_add(&bar[XB_XGEN(b.x)], 1u);
            asm volatile("s_waitcnt vmcnt(0)" ::: "memory");
        } else {
            XB_SPIN(xb_ld(&bar[XB_XGEN(b.x)]) == gen, bar);
            __builtin_amdgcn_fence(__ATOMIC_ACQUIRE, "agent");
            asm volatile("s_waitcnt vmcnt(0)" ::: "memory");
        }
    }
    __syncthreads();
}


__global__ void __launch_bounds__(512, 2) fwd_kernel(Args args) {
    extern __shared__ __attribute__((aligned(16))) unsigned char lds_raw[];
    LAS unsigned char* lds = (LAS unsigned char*)lds_raw;
    const int G = gridDim.x, bid = blockIdx.x;
    typedef const __attribute__((address_space(4))) unsigned char* kptr_t;
    const kptr_t kbase = (kptr_t)__builtin_amdgcn_kernarg_segment_ptr();
#define INP(idx) ({ kptr_t _k = kbase; asm volatile("" : "+s"(_k)); *(const float* const __attribute__((address_space(4)))*)(_k + 8 * (idx)); })
#define WSP(T, off) ({ kptr_t _k = kbase; asm volatile("" : "+s"(_k)); (T*)(*(unsigned char* const __attribute__((address_space(4)))*)(_k + 200) + (off)); })
#define x_in INP(0)
#define c_in INP(1)
#define norm1_g INP(2)
#define norm2_g INP(3)
#define w_ada INP(4)
#define b_ada INP(5)
#define w_in INP(6)
#define q_norm_g INP(7)
#define k_norm_g INP(8)
#define rel_bias INP(9)
#define lam_re INP(10)
#define lam_im INP(11)
#define log_dt INP(12)
#define b_re INP(13)
#define b_im INP(14)
#define c_re INP(15)
#define c_im INP(16)
#define ssm_d INP(17)
#define w_glu INP(18)
#define attn_out_g INP(19)
#define ssm_out_g INP(20)
#define w_out INP(21)
#define w_mlp1 INP(22)
#define w_mlp2 INP(23)
#define OUTP ({ kptr_t _k = kbase; asm volatile("" : "+s"(_k)); *(float* const __attribute__((address_space(4)))*)(_k + 192); })
#define MOD WSP(float, WS_MOD)
#define GM1 WSP(float, WS_GM1)
#define GM2 WSP(float, WS_GM2)
#define TBLG WSP(float, WS_TBLG)
#define SHW1 WSP(float, WS_SHW1)
#define SHW2 WSP(float, WS_SHW2)
#define PW WSP(f32x2, WS_PW)
#define BBAR WSP(f32x2, WS_BBAR)
#define KT WSP(float, WS_KT)
#define STATX WSP(float, WS_STATX)
#define STATS WSP(float, WS_STATS)
#define WQKU WSP(bf16_t, WS_WQKU)
#define WV WSP(bf16_t, WS_WV)
#define WGLU WSP(bf16_t, WS_WGLU)
#define WOUT WSP(bf16_t, WS_WOUT)
#define W1 WSP(bf16_t, WS_W1)
#define W2 WSP(bf16_t, WS_W2)
#define BT3 WSP(bf16_t, WS_BT3)
#define QS1 WSP(bf16_t, WS_QS1)
#define AX WSP(bf16_t, WS_AX)
#define QB WSP(bf16_t, WS_QB)
#define KB WSP(bf16_t, WS_KB)
#define VT WSP(bf16_t, WS_VT)
#define A3 WSP(bf16_t, WS_A3)
#define LB WSP(float, WS_LB)
#define Z WSP(bf16_t, WS_Z)
#define MIX WSP(bf16_t, WS_MIX)
#define HB WSP(bf16_t, WS_H)
    const int lo = args.ph_lo, hi = args.ph_hi;
    volatile LAS unsigned* xb_st = (volatile LAS unsigned*)(lds + LDS_BYTES - 16);
    if (threadIdx.x == 0) { xb_st[0] = 0u; xb_st[1] = 0u; }
    __syncthreads();
    XcdBarrier xbar = xcd_barrier_post(WSP(unsigned, 0), xb_st);
    for (int ph = lo; ph < hi; ++ph) {
      const int cls_ = ph < 3 ? ph : 3 + ((ph - 3) & 7);
      const int nrep_ = ((((DUPM) >> cls_) & 1u) && !(cls_ == 8 && ph >= 11) && cls_ != 10) ? 2 : 1;
      for (int rep_ = 0; rep_ < nrep_; ++rep_) {
        if ((ph > lo || rep_) && cls_ != 5) { if (hi < 0) cg::this_grid().sync(); else xcd_barrier(xbar); }
        int tid = threadIdx.x; asm volatile("" : "+v"(tid));
        const int lane = tid & 63, wave = __builtin_amdgcn_readfirstlane(tid >> 6);
        const int gw = bid * 8 + wave, NGW = G * 8;
        const int gt = bid * 512 + tid, NGT = G * 512;
        if (ph == 0) { if (PHON(0)) {
            if (bid < 192) {
                LAS bf16_t* S16 = (LAS bf16_t*)lds;
                { const float* cp = c_in; for (int i = tid; i < NB * DM; i += 512) { const float v = cp[i]; S16[(i >> 10) * S16_LD + (i & 1023)] = (bf16_t)f2bf(v * __builtin_amdgcn_rcpf(1.0f + __builtin_amdgcn_exp2f(-LOG2E * v))); } }
                __syncthreads();
                const int l = bid / 96, chunk = bid % 96;
                gemv32_task(lds, w_ada + (size_t)l * DM * (NMOD * DM), NMOD * DM, chunk * 64, b_ada + (size_t)l * NMOD * DM, MOD + (size_t)l * NB * NMOD * DM, NMOD * DM, tid);
            }
            {
                LAS float* scr = (LAS float*)(lds + wave * 16384);
                constexpr int I_QKU = 48 * 16, I_V = 16 * 16, I_GLU = 16 * 8, I_OUT = 32 * 16, I_1 = 128 * 16, I_2 = 32 * 64, I_L = I_QKU + I_V + I_GLU + I_OUT + I_1 + I_2;
                constexpr int NA = 2560;
                const bool front = (G == 256);
                for (int pass = 0; pass < 2; ++pass)
                for (int it = front ? (pass == 0 ? (bid >= 192 ? (bid - 192) * 8 + wave : 2 * I_L) : NA + gw) : (pass == 0 ? gw : 2 * I_L); it < (front && pass == 0 ? NA : 2 * I_L); it += (front && pass == 0 ? 512 : NGW)) {
                    const int l = it / I_L; int r = it % I_L;
                    if (r < I_QKU) { const int nb = r / 16, kb = r % 16, pn = nb >> 3, lb = nb & 7;
                        const int src = (pn < 4 ? 256 * pn : 1536 + 256 * (pn - 4)) + 64 * (lb & 3) + 32 * (lb >> 2);
                        transpose_item(w_in + (size_t)l * DM * INC, INC, 64 * kb, src, WQKU + (size_t)l * 1536 * DM, DM, 32 * nb, 64 * kb, scr, lane); continue; } r -= I_QKU;
                    if (r < I_V) { const int nb = r / 16, kb = r % 16;
                        transpose_item(w_in + (size_t)l * DM * INC, INC, 64 * kb, 1024 + 32 * nb, WV + (size_t)l * 512 * DM, DM, 32 * nb, 64 * kb, scr, lane); continue; } r -= I_V;
                    if (r < I_GLU) { const int nb = r / 8, kb = r % 8;
                        transpose_item(w_glu + (size_t)l * SW * SW, SW, 64 * kb, 32 * nb, WGLU + (size_t)l * SW * SW, SW, 32 * nb, 64 * kb, scr, lane); continue; } r -= I_GLU;
                    if (r < I_OUT) { const int nb = r / 16, kb = r % 16;
                        transpose_item(w_out + (size_t)l * DM * DM, DM, 64 * kb, 32 * nb, WOUT + (size_t)l * DM * DM, DM, 32 * nb, 64 * kb, scr, lane); continue; } r -= I_OUT;
                    if (r < I_1) { const int nb = r / 16, kb = r % 16;
                        transpose_item(w_mlp1 + (size_t)l * DM * DFF, DFF, 64 * kb, 32 * nb, W1 + (size_t)l * DFF * DM, DM, 32 * nb, 64 * kb, scr, lane); continue; } r -= I_1;
                    { const int nb = r / 64, kb = r % 64;
                        transpose_item(w_mlp2 + (size_t)l * DFF * DM, DM, 64 * kb, 32 * nb, W2 + (size_t)l * DM * DFF, DFF, 32 * nb, 64 * kb, scr, lane); }
                }
            }
            for (int idx = gt; idx < DEPTH * 2 * NG * SP; idx += NGT) {
                const int p = idx & 63, ldg = idx >> 6, gi = ldg & 31;
                const double lre = fmin((double)lam_re[idx], -1e-4), lim = (double)lam_im[idx];
                const double dt = (double)expf(log_dt[ldg]);
                double sn, cs; dsincos_red(lim * dt, sn, cs); const double mg = dexp_small(lre * dt);
                const double lbr = mg * cs, lbi = mg * sn;
                double pr = 1.0, pi = 0.0;
                f32x2* pw = PW + (size_t)ldg * 33 * 64 + p;
#pragma unroll 1
                for (int d = 0; d <= 32; ++d) { pw[d * 64] = (f32x2){(float)pr, (float)pi}; const double nr = pr * lbr - pi * lbi, ni = pr * lbi + pi * lbr; pr = nr; pi = ni; }
                const double den = lre * lre + lim * lim, cr = ((lbr - 1.0) * lre + lbi * lim) / den, ci = (lbi * lre - (lbr - 1.0) * lim) / den;
                (void)gi;
#pragma unroll 1
                for (int h = 0; h < SG; ++h) { const double br = (double)b_re[(size_t)idx * SG + h], bi = (double)b_im[(size_t)idx * SG + h];
                    BBAR[(size_t)idx * SG + h] = (f32x2){(float)(cr * br - ci * bi), (float)(cr * bi + ci * br)}; }
            }
        } } else if (ph == 1) { if (PHON(1)) {
            for (int i = gt; i < DEPTH * NB * DM; i += NGT) { const int k = i & 1023, lb = i >> 10, l = lb >> 5;
                GM1[i] = norm1_g[l * DM + k] * (1.0f + MOD[(size_t)lb * (NMOD * DM) + 1 * DM + k]);
                GM2[i] = norm2_g[l * DM + k] * (1.0f + MOD[(size_t)lb * (NMOD * DM) + 4 * DM + k]); }
            for (int l2 = 0; l2 < DEPTH; ++l2) {
                LAS float* redl = (LAS float*)(lds + 32768);
                float mq = fabsf(q_norm_g[l2 * HD + lane]), mk = fabsf(k_norm_g[l2 * HD + lane]), mb = 0.f;
                const float* relb = rel_bias + (size_t)l2 * NH * 15 * 31;
                for (int i = tid; i < NH * 15 * 31; i += 512) mb = fmaxf(mb, fabsf(relb[i]));
#pragma unroll
                for (int o = 1; o < 64; o <<= 1) { mq = fmaxf(mq, __shfl_xor(mq, o)); mk = fmaxf(mk, __shfl_xor(mk, o)); mb = fmaxf(mb, __shfl_xor(mb, o)); }
                if (lane == 0) redl[wave] = mb;
                __syncthreads();
#pragma unroll
                for (int w = 0; w < 8; ++w) mb = fmaxf(mb, redl[w]);
                const float cshift = 8.0f * mq * mk + mb;
                float* tg = TBLG + (size_t)l2 * NH * 15 * 128;
                for (int i = gt; i < NH * 15 * 128; i += NGT) { const int x = (i & 127) - 48, hd = i >> 7; tg[i] = (x >= 0 && x <= 30) ? (relb[hd * 31 + x] - cshift) * LOG2E : 0.f; }
                __syncthreads();
            }
            for (int t = bid; t < 256; t += G) {
                const int l = t >> 7, gi = (t >> 2) & 31, dir = (t >> 1) & 1, dh = t & 1, ldg = (l * 2 + dir) * 32 + gi;
                LAS f32x2* pwl = (LAS f32x2*)lds; LAS f32x2* bbl = (LAS f32x2*)(lds + 8192); LAS float* crl = (LAS float*)(lds + 16384); LAS float* cil = (LAS float*)(lds + 20480);
                { const f32x2* pwg = PW + ((size_t)ldg * 33 + 16 * dh) * 64; const f32x2* bbg = BBAR + (size_t)ldg * 1024; const float* crg = c_re + (size_t)ldg * 1024; const float* cig = c_im + (size_t)ldg * 1024;
                  for (int i = tid; i < 1024; i += 512) { pwl[i] = pwg[i]; bbl[i] = bbg[i]; crl[i] = crg[i]; cil[i] = cig[i]; } }
                __syncthreads();
                const int ci = tid & 15, ch = (tid >> 4) & 15, dsub = tid >> 8;
                float a8[8];
#pragma unroll
                for (int e = 0; e < 8; ++e) a8[e] = 0.f;
                for (int p = 0; p < 64; ++p) {
                    const f32x2 bv = bbl[p * 16 + ci]; const float c_r = crl[ch * 64 + p], c_i = cil[ch * 64 + p];
                    const float cbr = c_r * bv.x - c_i * bv.y, cbi = c_r * bv.y + c_i * bv.x;
#pragma unroll
                    for (int e = 0; e < 8; ++e) { const f32x2 w = pwl[(dsub * 8 + e) * 64 + p]; a8[e] += cbr * w.x - cbi * w.y; }
                }
                float* ktp = KT + ((size_t)((l * NG + gi) * 2 + dir) * 32 + 16 * dh + dsub * 8) * 256 + ch * 16 + ci;
#pragma unroll
                for (int e = 0; e < 8; ++e) ktp[e * 256] = a8[e];
                __syncthreads();
            }
            for (int i = gt; i < DEPTH * NG * 256 * 64; i += NGT) {
                const int k8 = i & 63, n = (i >> 6) & 255, gi = (i >> 14) & 31, l = i >> 19;
                const int dir = n >> 7, ri = (n >> 6) & 1, p = n & 63, s = k8 >> 1, ci0 = (k8 & 1) * 8;
                const int ldg = (l * 2 + dir) * 32 + gi, dl = dir == 0 ? 31 - s : s;
                const f32x2 w = PW[((size_t)ldg * 33 + dl) * 64 + p]; const f32x2* bb = BBAR + ((size_t)ldg * 64 + p) * 16 + ci0;
                float v[8];
#pragma unroll
                for (int e = 0; e < 8; ++e) { const f32x2 bv = bb[e]; v[e] = ri ? (w.x * bv.y + w.y * bv.x) : (w.x * bv.x - w.y * bv.y); }
                u32x4 o; o.x = pk2(v[0], v[1]); o.y = pk2(v[2], v[3]); o.z = pk2(v[4], v[5]); o.w = pk2(v[6], v[7]);
                *(u32x4*)(QS1 + ((size_t)(l * NG + gi) * 256 + n) * 512 + k8 * 8) = o;
            }
            for (int i = gt; i < DEPTH * NG * 512 * 32; i += NGT) {
                const int kk8 = i & 31, n = (i >> 5) & 511, gi = (i >> 14) & 31, l = i >> 19;
                const int kk = kk8 * 8, dir = kk >> 7, ri = (kk >> 6) & 1, p0 = kk & 63, tau = n >> 4, ch = n & 15;
                const int ldg = (l * 2 + dir) * 32 + gi, e0 = dir == 0 ? tau + 1 : 32 - tau;
                const f32x2* pw = PW + ((size_t)ldg * 33 + e0) * 64 + p0; const float* cr = c_re + ((size_t)ldg * 16 + ch) * 64 + p0; const float* cim = c_im + ((size_t)ldg * 16 + ch) * 64 + p0;
                float v[8];
#pragma unroll
                for (int e = 0; e < 8; ++e) { const f32x2 w = pw[e]; v[e] = ri ? -(cr[e] * w.y + cim[e] * w.x) : (cr[e] * w.x - cim[e] * w.y); }
                u32x4 o; o.x = pk2(v[0], v[1]); o.y = pk2(v[2], v[3]); o.z = pk2(v[4], v[5]); o.w = pk2(v[6], v[7]);
                *(u32x4*)(BT3 + ((size_t)(l * NG + gi) * 512 + n) * 768 + 512 + kk) = o;
            }
        } } else if (ph == 2) { if (PHON(2)) {
            if (bid < 192) {
                const int l = bid / 96, t = bid % 96;
                LAS bf16_t* S16 = (LAS bf16_t*)lds;
                const float* src = MOD + (size_t)l * NB * NMOD * DM + (t < 32 ? 0 : 3 * DM);
                for (int i = tid; i < NB * DM; i += 512) S16[(i >> 10) * S16_LD + (i & 1023)] = (bf16_t)f2bf(src[(size_t)(i >> 10) * (NMOD * DM) + (i & 1023)]);
                __syncthreads();
                if (t < 32) gemv32_task(lds, w_in + (size_t)l * DM * INC, INC, t * 64, nullptr, SHW1 + (size_t)l * NB * INC, INC, tid);
                else gemv32_task(lds, w_mlp1 + (size_t)l * DM * DFF, DFF, (t - 32) * 64, nullptr, SHW2 + (size_t)l * NB * DFF, DFF, tid);
            }
            {
                const float* ktp = KT; const float* dsp = ssm_d; bf16_t* bt3p = BT3;
                for (int i = gt; i < DEPTH * NG * 512 * 64; i += NGT) {
                    const int k8 = i & 63, n = (i >> 6) & 511, gi = (i >> 15) & 31, l = i >> 20;
                    const int s_ = k8 >> 1, ci0 = (k8 & 1) * 8, tau = n >> 4, ch = n & 15;
                    const float* ktg = ktp + ((size_t)(l * NG + gi) * 2) * 32 * 256;
                    const int dir = s_ > tau ? 1 : 0, dl = s_ > tau ? s_ - tau : tau - s_;
                    const f32x4* kp = (const f32x4*)(ktg + ((size_t)(dir * 32 + dl) * 16 + ch) * 16 + ci0);
                    f32x4 va = kp[0], vb = kp[1];
                    if (s_ == tau) { const f32x4* kq = (const f32x4*)(ktg + ((size_t)(32) * 16 + ch) * 16 + ci0); va = va + kq[0]; vb = vb + kq[1];
                        const float dsk = dsp[(size_t)(l * NG + gi) * SG + ch]; const int e = ch - ci0;
                        if (e >= 0 && e < 4) va[e] += dsk; else if (e >= 4 && e < 8) vb[e - 4] += dsk; }
                    u32x4 o; o.x = pk2(va[0], va[1]); o.y = pk2(va[2], va[3]); o.z = pk2(vb[0], vb[1]); o.w = pk2(vb[2], vb[3]);
                    *(u32x4*)(bt3p + ((size_t)(l * NG + gi) * 512 + n) * 768 + k8 * 8) = o;
                }
            }
            {
                const float* xp = x_in; const float* gmp = GM1; bf16_t* axp = AX; float* stp = STATX;
                constexpr int RA = 8192;
                const bool front = (G == 256);
                for (int pass = 0; pass < 2; ++pass)
                for (int rp = front ? (pass == 0 ? (bid >= 192 ? (bid - 192) * 8 + wave : NTOK) : RA / 2 + gw) : (pass == 0 ? gw : NTOK); rp < (front && pass == 0 ? RA / 2 : NTOK / 2); rp += (front && pass == 0 ? 512 : NGW)) {
                    const int row = 2 * rp, b = row >> 11;
                    const f32x4* xr = (const f32x4*)(xp + (size_t)row * DM) + lane; const f32x4* gmr = (const f32x4*)(gmp + (size_t)b * DM) + lane;
                    f32x4 v[8];
#pragma unroll
                    for (int j = 0; j < 8; ++j) v[j] = xr[64 * j];
                    u32x2* o8 = (u32x2*)(axp + (size_t)row * DM) + lane; float s0 = 0.f, s1 = 0.f;
#pragma unroll
                    for (int j = 0; j < 8; ++j) { if (j < 4) s0 += sq4(v[j]); else s1 += sq4(v[j]); const f32x4 a = v[j] * gmr[64 * (j & 3)]; u32x2 w; w.x = cvt_pk_bf16(a[0], a[1]); w.y = cvt_pk_bf16(a[2], a[3]); o8[64 * j] = w; }
                    s0 = wave_sum(s0); s1 = wave_sum(s1);
                    if (lane < 32) stp[(size_t)row * 16 + lane] = lane == 0 ? s0 : (lane == 16 ? s1 : 0.f);
                }
            }
        } } else {
            const int l = (ph - 3) >> 3, sub = (ph - 3) & 7;
            const float* modl = MOD + (size_t)l * NB * NMOD * DM;
            if (sub == 0) { if (PHON(3)) {
                { pg8::Gemm g{AX, WQKU + (size_t)l * 1536 * DM, DM, DM, DM}; pg8::StaticOrder S; S.init(NTOK, 1536, G, bid); S.rev = (l > 0);
                  EpiIn E{STATX, SHW1 + (size_t)l * NB * INC, q_norm_g + l * HD, k_norm_g + l * HD, QB, A3, (LAS float*)(lds + 131072)};
                  pg8::gemm_phase<EpiIn, pg8::StaticOrder, true>(lds, g, S, E); }
                { pg8::Gemm g{WV + (size_t)l * 512 * DM, AX, DM, DM, DM}; pg8::StaticOrder S; S.init(512, NTOK, G, bid);
                  EpiVt E{STATX, SHW1 + (size_t)l * NB * INC, VT, (LAS float*)(lds + 131072)};
                  pg8::gemm_phase<EpiVt, pg8::StaticOrder, true>(lds, g, S, E); }
            } } else if (sub == 1) { if (PHON(4)) {
#ifndef NO_S1
                if (G == 256) {
                    if (!(DUP_ONLY_ATTN && rep_)) {
                    pg8::Gemm g{A3, QS1 + (size_t)l * NG * 256 * 512, 768, 512, 512}; pg8::GroupOrder<1> S; S.init(G, bid);
                    EpiS1F E{PW + (size_t)l * 2 * 32 * 33 * 64, A3};
                    pg8::gemm_phase<EpiS1F, pg8::GroupOrder<1>, true>(lds, g, S, E); }
                } else {
                if (!(DUP_ONLY_ATTN && rep_))
                { pg8::Gemm g{A3, QS1 + (size_t)l * NG * 256 * 512, 768, 512, 512}; pg8::GroupOrder<1> S; S.init(G, bid);
                  EpiS1 E{LB};
                  pg8::gemm_phase<EpiS1, pg8::GroupOrder<1>, true>(lds, g, S, E); }
                for (int L_ = bid; L_ < 256; L_ += G) {
                    const int p = tid & 63, dir = (tid >> 6) & 1, gi = L_ >> 3, b = 4 * (L_ & 7) + (tid >> 7);
                    const f32x2 w = PW[((size_t)((l * 2 + dir) * 32 + gi) * 33 + 32) * 64 + p];
                    float hr = 0.f, hi_ = 0.f;
                    const size_t rbase = (size_t)gi * 2048 + b * NCH;
                    const float* LBp = LB; bf16_t* A3p = A3;
                    for (int c8 = 0; c8 < NCH; c8 += 8) {
                        float lr[8], li[8];
#pragma unroll
                        for (int e = 0; e < 8; ++e) { const int ch = dir == 0 ? c8 + e : NCH - 1 - (c8 + e); const float* lp = LBp + (rbase + ch) * 256 + dir * 128 + p; lr[e] = lp[0]; li[e] = lp[64]; }
#pragma unroll
                        for (int e = 0; e < 8; ++e) { const int ch = dir == 0 ? c8 + e : NCH - 1 - (c8 + e);
                            bf16_t* ap = A3p + (rbase + ch) * 768 + 512 + dir * 128 + p;
                            ap[0] = (bf16_t)f2bf(hr); ap[64] = (bf16_t)f2bf(hi_);
                            const float nr = w.x * hr - w.y * hi_ + lr[e], ni = w.x * hi_ + w.y * hr + li[e];
                            hr = nr; hi_ = ni; }
                    }
                }
                }
#endif
#ifndef NO_ATTN
                attn_phase(lds, QB, KB, VT, MIX, TBLG + (size_t)l * NH * 15 * 128, attn_out_g + l * AW);
#endif
            } } else if (sub == 2) { if (PHON(5)) {
                (void)0;
            } } else if (sub == 3) { if (PHON(6)) {
                pg8::Gemm g{A3, BT3 + (size_t)l * NG * 512 * 768, 768, 768, 768}; pg8::GroupOrder<2> S; S.init(G, bid);
                EpiS3 E{Z};
                pg8::gemm_phase<EpiS3, pg8::GroupOrder<2>, true>(lds, g, S, E);
            } } else if (sub == 4) { if (PHON(7)) {
                pg8::Gemm g{Z, WGLU + (size_t)l * SW * SW, SW, SW, SW}; pg8::PairOrder S; S.init(G, bid);
                EpiGlu E{Z, ssm_out_g + l * SW, STATS, MIX};
                pg8::gemm_phase<EpiGlu, pg8::PairOrder, true>(lds, g, S, E);
                __builtin_amdgcn_fence(__ATOMIC_RELEASE, "workgroup"); __syncthreads(); __builtin_amdgcn_fence(__ATOMIC_ACQUIRE, "workgroup");
                for (int pm = bid; pm < 256; pm += G)
                    for (int r0_ = wave; r0_ < 256; r0_ += 64) {
                        u32x4 wv[8]; float rsv[8];
                        const float* stp = STATS; bf16_t* mixp = MIX;
#pragma unroll
                        for (int e = 0; e < 8; ++e) { const int row = pm * 256 + r0_ + 8 * e;
                            const f32x4* sp = (const f32x4*)(stp + (size_t)row * 8);
                            rsv[e] = rsq((sum4(sp[0]) + sum4(sp[1])) * (1.0f / SW) + EPS);
                            wv[e] = *((const u32x4*)(mixp + (size_t)row * DM + AW) + lane); }
                        asm volatile("" ::: "memory");
#pragma unroll
                        for (int e = 0; e < 8; ++e) { const int row = pm * 256 + r0_ + 8 * e; const float rs = rsv[e]; u32x4 w = wv[e];
                            w.x = cvt_pk_bf16(bf_lo(w.x) * rs, bf_hi(w.x) * rs); w.y = cvt_pk_bf16(bf_lo(w.y) * rs, bf_hi(w.y) * rs);
                            w.z = cvt_pk_bf16(bf_lo(w.z) * rs, bf_hi(w.z) * rs); w.w = cvt_pk_bf16(bf_lo(w.w) * rs, bf_hi(w.w) * rs);
                            *((u32x4*)(mixp + (size_t)row * DM + AW) + lane) = w; }
                    }
            } } else if (sub == 5) { if (PHON(8)) {
                pg8::Gemm g{MIX, WOUT + (size_t)l * DM * DM, DM, DM, DM}; pg8::StaticOrder S; S.init(NTOK, DM, G, bid);
                EpiRes E{l == 0 ? x_in : (const float*)OUTP, OUTP, modl + 2 * DM, NMOD * DM, GM2 + (size_t)l * NB * DM, AX, STATX, (LAS float*)(lds + 131072 + 1024)};
                pg8::gemm_phase<EpiRes, pg8::StaticOrder, true>(lds, g, S, E);
            } } else if (sub == 6) { if (PHON(9)) {
                pg8::Gemm g{AX, W1 + (size_t)l * DFF * DM, DM, DM, DM}; pg8::StaticOrder S; S.init(NTOK, DFF, G, bid); S.rev = 1;
                EpiMlp1 E{STATX, SHW2 + (size_t)l * NB * DFF, HB, (LAS float*)(lds + 131072)};
                pg8::gemm_phase<EpiMlp1, pg8::StaticOrder, true>(lds, g, S, E);
            } } else { if (PHON(10)) {
                pg8::Gemm g{HB, W2 + (size_t)l * DM * DFF, DFF, DFF, DFF}; pg8::StaticOrder S; S.init(NTOK, DM, G, bid);
                EpiRes E{OUTP, OUTP, modl + 5 * DM, NMOD * DM, (l + 1 < DEPTH) ? GM1 + (size_t)(l + 1) * NB * DM : nullptr, AX, STATX, (LAS float*)(lds + 131072 + 1024)};
                pg8::gemm_phase<EpiRes, pg8::StaticOrder, true>(lds, g, S, E);
            } }
        }
      }
    }
}

extern "C" void kernel_launch(void* const* d_in, const int* in_sizes, int n_in, void* d_out, int out_size, void* d_ws, size_t ws_size, hipStream_t stream) {
    static int grid = 0;
    if (grid == 0) {
        if (n_in != 24 || ws_size < WS_END) { fprintf(stderr, "kernel_launch: unexpected n_in %d / ws %zu\n", n_in, ws_size); grid = -1; return; }
        int dev = 0, cus = 0;
        hipGetDevice(&dev); hipDeviceGetAttribute(&cus, hipDeviceAttributeMultiprocessorCount, dev);
        if (hipFuncSetAttribute((const void*)fwd_kernel, hipFuncAttributeMaxDynamicSharedMemorySize, LDS_BYTES) != hipSuccess) { fprintf(stderr, "kernel_launch: hipFuncSetAttribute failed\n"); grid = -1; return; }
        int per_cu = 0;
        if (hipOccupancyMaxActiveBlocksPerMultiprocessor(&per_cu, (const void*)fwd_kernel, 512, LDS_BYTES) != hipSuccess || per_cu < 1) { fprintf(stderr, "kernel_launch: occupancy query says %d\n", per_cu); per_cu = 1; }
        (void)hipGetLastError();
        grid = cus > 0 ? cus : 256;
    }
    if (grid < 0) return;
    Args a{};
    for (int i = 0; i < 24; ++i) a.in[i] = (const float*)d_in[i];
    a.out = (float*)d_out; a.ws = (unsigned char*)d_ws;
#if N_LAUNCH_PER_PHASE
    for (int ph = 0; ph < NPH; ++ph) { a.ph_lo = ph; a.ph_hi = ph + 1; hipLaunchKernelGGL(fwd_kernel, dim3(grid), dim3(512), LDS_BYTES, stream, a); }
#else
    a.ph_lo = 0; a.ph_hi = NPH;
    if (hipMemsetAsync(d_ws, 0, 16384, stream) != hipSuccess) { fprintf(stderr, "kernel_launch: memset of the barrier words failed\n"); return; }
    void* kargs[] = {&a};
    hipError_t e = hipLaunchCooperativeKernel((const void*)fwd_kernel, dim3(grid), dim3(512), kargs, LDS_BYTES, stream);
    if (e != hipSuccess) fprintf(stderr, "cooperative launch failed: %s (grid %d)\n", hipGetErrorString(e), grid);
#endif
}
```
